# Optimizing an MI355X kernel written in HIP

```python
import math
import jax, jax.numpy as jnp
from jax import lax
import numpy as np

D_MODEL = 1024
BATCH = 8
SEQ = 4096
DEPTH = 2

CTX_LEN = 256
GRID_W = 64
N_MIXERS = 2
EXPAND = 2
D_INNER = EXPAND * D_MODEL
HG_DK = 128
HG_HEADS = D_INNER // HG_DK
HG_DV = D_INNER // HG_HEADS
HG_CHUNK = 32
HG_IN_COLS = 5 * D_INNER
DA_HEADS = 16
DA_DQK = 64
DA_DV = 2 * DA_DQK
DA_IN_COLS = 4 * D_INNER
Q_BLOCK = 128
ROPE_THETA = 10000.0
EPS = 1e-6
N_HGRN_LAYERS = (DEPTH + N_MIXERS - 1) // N_MIXERS
N_DIFF_LAYERS = DEPTH // N_MIXERS

kernel_name = "hybrid_hgrn2_diffattn_dit_block"

F32 = jnp.float32


def rmsnorm(x, g):
    xf = x.astype(F32)
    y = xf * lax.rsqrt(jnp.mean(xf * xf, axis=-1, keepdims=True) + EPS)
    return (y * g.astype(F32)).astype(x.dtype)


def modulate(x, g, shift, scale):
    return rmsnorm(x, g) * (1 + scale) + shift


def _heads(t, n_heads):
    B, L, _ = t.shape
    return t.reshape(B, L, n_heads, -1).transpose(0, 2, 1, 3)


def gla_scan(q, k, v, logf, s0):
    B, H, L, DK = q.shape
    DV = v.shape[-1]
    n = L // HG_CHUNK

    def to_chunks(t):
        return jnp.moveaxis(t.reshape(B, H, n, HG_CHUNK, t.shape[-1]), 2, 0)

    mask = jnp.tril(jnp.ones((HG_CHUNK, HG_CHUNK), dtype=bool))

    def step(s, inp):
        qc, kc, vc, gc = inp
        b = jnp.cumsum(gc, axis=2)
        o_inter = jnp.einsum('bhck,bhkv->bhcv', qc * jnp.exp(b), s)
        d = b[:, :, :, None, :] - b[:, :, None, :, :]
        decay = jnp.exp(jnp.where(mask[:, :, None], d, -jnp.inf))
        a = jnp.einsum('bhik,bhjk,bhijk->bhij', qc, kc, decay)
        o_intra = jnp.einsum('bhij,bhjv->bhiv', a, vc)
        b_last = b[:, :, -1:, :]
        s_new = jnp.exp(b_last[:, :, 0, :])[..., None] * s + jnp.einsum(
            'bhck,bhcv->bhkv', kc * jnp.exp(b_last - b), vc)
        return s_new, o_inter + o_intra

    s_fin, o = lax.scan(step, s0, (to_chunks(q), to_chunks(k), to_chunks(v), to_chunks(logf)))
    o = jnp.moveaxis(o, 0, 2).reshape(B, H, L, DV)
    return o, s_fin


def hgrn2_project(h, w_in, lb_fwd, lb_bwd):
    q, zf, zb, i, gate = jnp.split(h @ w_in, 5, axis=-1)
    q = jax.nn.silu(q.astype(F32))

    def forget(z, lb):
        z = z.astype(F32)
        logf = jnp.log(lb + (1 - lb) * jax.nn.sigmoid(z))
        k = (1 - lb) * jax.nn.sigmoid(-z)
        return _heads(k, HG_HEADS), _heads(logf, HG_HEADS)

    kf, gf = forget(zf, lb_fwd)
    kb, gb = forget(zb, lb_bwd)
    return _heads(q, HG_HEADS), kf, gf, kb, gb, _heads(i.astype(F32), HG_HEADS), gate


def hgrn2_bidir(q, kf, gf, kb, gb, v, s0f, s0b):
    flip = lambda t: jnp.flip(t, axis=2)
    of, sf = gla_scan(q, kf, v, gf, s0f)
    ob, sb = gla_scan(flip(q), flip(kb), flip(v), flip(gb), s0b)
    return of + flip(ob), sf, sb


def hgrn2_readout(o, gate, norm_g, w_out, dtype):
    B, H, L, DV = o.shape
    o = o * lax.rsqrt(jnp.mean(o * o, axis=-1, keepdims=True) + EPS)
    o = o.transpose(0, 2, 1, 3).reshape(B, L, H * DV) * norm_g.astype(F32)
    return (o * jax.nn.silu(gate.astype(F32))).astype(dtype) @ w_out


def hgrn2_mixer(h_ctx, h_lat, w_in, lb_fwd, lb_bwd, norm_g, w_out, emit_ctx):
    dtype = h_lat.dtype
    B = h_lat.shape[0]
    s0 = jnp.zeros((B, HG_HEADS, HG_DK, HG_DV), F32)
    qc, kfc, gfc, kbc, gbc, vc, gc = hgrn2_project(h_ctx, w_in, lb_fwd, lb_bwd)
    o_ctx, s_cf, s_cb = hgrn2_bidir(qc, kfc, gfc, kbc, gbc, vc, s0, s0)
    ql, kfl, gfl, kbl, gbl, vl, gl = hgrn2_project(h_lat, w_in, lb_fwd, lb_bwd)
    o_lat, _, _ = hgrn2_bidir(ql, kfl, gfl, kbl, gbl, vl, s_cf, s_cb)
    y_lat = hgrn2_readout(o_lat, gl, norm_g, w_out, dtype)
    y_ctx = hgrn2_readout(o_ctx, gc, norm_g, w_out, dtype) if emit_ctx else None
    return y_ctx, y_lat


def axial_rope_tables(row, col, dtype):
    ax = DA_DQK // 2
    inv = 1.0 / (ROPE_THETA ** (jnp.arange(0, ax, 2, dtype=F32) / ax))
    L = row.shape[0]
    ang_r = row.astype(F32)[:, None] * inv
    ang_c = col.astype(F32)[:, None] * inv
    shp = (1, L, 1, 1, ax // 2)
    return (jnp.cos(ang_r).reshape(shp).astype(dtype), jnp.sin(ang_r).reshape(shp).astype(dtype),
            jnp.cos(ang_c).reshape(shp).astype(dtype), jnp.sin(ang_c).reshape(shp).astype(dtype))


def _rot(x, cos, sin):
    x1, x2 = jnp.split(x, 2, axis=-1)
    return jnp.concatenate([x1 * cos - x2 * sin, x2 * cos + x1 * sin], axis=-1)


def apply_axial_rope(x, cos_r, sin_r, cos_c, sin_c):
    xr, xc = jnp.split(x, 2, axis=-1)
    return jnp.concatenate([_rot(xr, cos_r, sin_r), _rot(xc, cos_c, sin_c)], axis=-1)


def diff_softmax(q, k, v, lam):
    s = jnp.einsum('bqhpd,bkhpd->bhpqk', q, k).astype(F32) * (DA_DQK ** -0.5)
    p = jax.nn.softmax(s, axis=-1)
    a = p[:, :, 0] - lam * p[:, :, 1]
    return jnp.einsum('bhqk,bkhv->bqhv', a, v.astype(F32))


def diff_attn_mixer(h_ctx, h_lat, w_in, lq1, lk1, lq2, lk2, subln_g, w_out, lambda_init, rope, emit_ctx):
    dtype = h_lat.dtype
    lam = (jnp.exp(jnp.sum(lq1.astype(F32) * lk1.astype(F32)))
           - jnp.exp(jnp.sum(lq2.astype(F32) * lk2.astype(F32))) + lambda_init)

    def project(h):
        B, L, _ = h.shape
        q, k, v, gate = jnp.split(h @ w_in, 4, axis=-1)
        return (q.reshape(B, L, DA_HEADS, 2, DA_DQK), k.reshape(B, L, DA_HEADS, 2, DA_DQK),
                v.reshape(B, L, DA_HEADS, DA_DV), gate)

    def readout(o, gate):
        B, L = o.shape[:2]
        o = o * lax.rsqrt(jnp.mean(o * o, axis=-1, keepdims=True) + EPS) * subln_g.astype(F32)
        o = (o * (1.0 - lambda_init)).reshape(B, L, D_INNER)
        return (o * jax.nn.silu(gate.astype(F32))).astype(dtype) @ w_out

    qc, kc, vc, gc = project(h_ctx)
    ql, kl, vl, gl = project(h_lat)
    ql = apply_axial_rope(ql, *rope)
    kl = apply_axial_rope(kl, *rope)
    keys = jnp.concatenate([kc, kl], axis=1)
    vals = jnp.concatenate([vc, vl], axis=1)

    B, L = ql.shape[:2]
    nb = L // Q_BLOCK
    qb = jnp.moveaxis(ql.reshape(B, nb, Q_BLOCK, DA_HEADS, 2, DA_DQK), 1, 0)
    o_lat = lax.map(lambda qq: diff_softmax(qq, keys, vals, lam), qb)
    o_lat = jnp.moveaxis(o_lat, 0, 1).reshape(B, L, DA_HEADS, DA_DV)
    y_lat = readout(o_lat, gl)
    y_ctx = readout(diff_softmax(qc, kc, vc, lam), gc) if emit_ctx else None
    return y_ctx, y_lat


def setup_inputs(seed: int = 0) -> dict:
    key = jax.random.key(seed)
    ks = jax.random.split(key, 20)

    def nrm(k, shape, s):
        return jax.random.normal(k, shape, F32) * s

    return {
        "x": nrm(ks[0], (BATCH, SEQ, D_MODEL), 1.0),
        "c": nrm(ks[1], (BATCH, D_MODEL), 1.0),
        "ctx": nrm(ks[2], (BATCH, CTX_LEN, D_MODEL), 1.0),
        "c_ctx": nrm(ks[3], (D_MODEL,), 1.0),
        "w_ada": nrm(ks[4], (DEPTH, D_MODEL, 3 * D_MODEL), 0.5 * D_MODEL ** -0.5),
        "b_ada": nrm(ks[5], (DEPTH, 3 * D_MODEL), 0.01),
        "norm_g": 1.0 + nrm(ks[6], (DEPTH, D_MODEL), 0.02),
        "hg_w_in": nrm(ks[7], (N_HGRN_LAYERS, D_MODEL, HG_IN_COLS), D_MODEL ** -0.5),
        "hg_lb_logits": nrm(ks[8], (N_HGRN_LAYERS + 1, 2, D_INNER), 0.5),
        "hg_norm_g": 1.0 + nrm(ks[9], (N_HGRN_LAYERS, D_INNER), 0.02),
        "hg_w_out": nrm(ks[10], (N_HGRN_LAYERS, D_INNER, D_MODEL), D_INNER ** -0.5),
        "da_w_in": nrm(ks[11], (N_DIFF_LAYERS, D_MODEL, DA_IN_COLS), D_MODEL ** -0.5),
        "da_lam_q1": nrm(ks[12], (N_DIFF_LAYERS, DA_DQK), 0.1),
        "da_lam_k1": nrm(ks[13], (N_DIFF_LAYERS, DA_DQK), 0.1),
        "da_lam_q2": nrm(ks[14], (N_DIFF_LAYERS, DA_DQK), 0.1),
        "da_lam_k2": nrm(ks[15], (N_DIFF_LAYERS, DA_DQK), 0.1),
        "da_subln_g": 1.0 + nrm(ks[16], (N_DIFF_LAYERS, DA_DV), 0.02),
        "da_w_out": nrm(ks[17], (N_DIFF_LAYERS, D_INNER, D_MODEL), D_INNER ** -0.5),
        "final_g": 1.0 + nrm(ks[18], (D_MODEL,), 0.02),
    }


def reference(x, c, ctx, c_ctx, w_ada, b_ada, norm_g, hg_w_in, hg_lb_logits, hg_norm_g, hg_w_out,
              da_w_in, da_lam_q1, da_lam_k1, da_lam_q2, da_lam_k2, da_subln_g, da_w_out, final_g):
    n_lat = x.shape[1]
    rows = n_lat // GRID_W
    row = jnp.broadcast_to(jnp.arange(rows, dtype=jnp.int32)[:, None], (rows, GRID_W)).reshape(-1)
    col = jnp.broadcast_to(jnp.arange(GRID_W, dtype=jnp.int32)[None, :], (rows, GRID_W)).reshape(-1)
    rope = axial_rope_tables(row, col, x.dtype)

    lb_all = jnp.cumsum(jax.nn.softmax(hg_lb_logits.astype(F32), axis=0), axis=0)

    sc = jax.nn.silu(c)
    scc = jax.nn.silu(c_ctx)
    x_lat, x_ctx = x, ctx
    for i in range(DEPTH):
        emit_ctx = i < DEPTH - 1
        shift, scale, gate = jnp.split(sc @ w_ada[i] + b_ada[i], 3, axis=-1)
        shift_c, scale_c, gate_c = jnp.split(scc @ w_ada[i] + b_ada[i], 3, axis=-1)
        h_lat = modulate(x_lat, norm_g[i], shift[:, None, :], scale[:, None, :])
        h_ctx = modulate(x_ctx, norm_g[i], shift_c, scale_c)
        j = i // N_MIXERS
        if i % N_MIXERS == 0:
            y_ctx, y_lat = hgrn2_mixer(h_ctx, h_lat, hg_w_in[j], lb_all[j, 0], lb_all[j, 1],
                                       hg_norm_g[j], hg_w_out[j], emit_ctx)
        else:
            lambda_init = 0.8 - 0.6 * math.exp(-0.3 * i)
            y_ctx, y_lat = diff_attn_mixer(h_ctx, h_lat, da_w_in[j], da_lam_q1[j], da_lam_k1[j],
                                           da_lam_q2[j], da_lam_k2[j], da_subln_g[j], da_w_out[j],
                                           lambda_init, rope, emit_ctx)
        x_lat = x_lat + gate[:, None, :] * y_lat
        if emit_ctx:
            x_ctx = x_ctx + gate_c * y_ctx
    return rmsnorm(x_lat, final_g)
```

```cpp
#include <hip/hip_runtime.h>
#include <hip/hip_cooperative_groups.h>
#include <stdint.h>
#include <stdio.h>
namespace cg = cooperative_groups;

#ifndef MULTI_LAUNCH
#define MULTI_LAUNCH 0
#endif

typedef unsigned short bf16_t;
typedef short bf16x8 __attribute__((ext_vector_type(8)));
typedef float f32x4 __attribute__((ext_vector_type(4)));
typedef float f32x16 __attribute__((ext_vector_type(16)));
typedef __bf16 bf2_t __attribute__((ext_vector_type(2)));
typedef float f2_t __attribute__((ext_vector_type(2)));
#define DI __device__ __forceinline__
constexpr int NTH = 512, NWV = 8;

constexpr int D = 1024, NB = 8, SEQ = 4096, CTX = 256, TPB = SEQ + CTX  ;
constexpr int DI_ = 2048, NH = 16;
constexpr int GB_ = 4;
constexpr int GROWS = GB_ * TPB;
constexpr int GLAT = GB_ * SEQ;
constexpr float EPS = 1e-6f;
constexpr float LAMBDA_INIT = 0.35550906759f;
constexpr float QSCALE = 0.125f * 1.4426950408889634f;

constexpr size_t OFF_MOD = 0;
constexpr size_t OFF_LB = 262144;
constexpr size_t OFF_SCAL = 262144 + 16384;
constexpr size_t OFF_WT_A = 1048576;
constexpr size_t OFF_WT_B = OFF_WT_A + 20971520;
constexpr size_t OFF_X1CTX = OFF_WT_B + 4194304;
constexpr size_t OFF_BIG = OFF_X1CTX + 8388608;
constexpr size_t PLANE = (size_t)GROWS * DI_ * 2;
constexpr size_t OFF_P1 = OFF_BIG;
constexpr size_t OFF_OF = OFF_P1 + 5 * PLANE;
constexpr size_t OFF_OB = OFF_OF + PLANE;
constexpr size_t WS_NEED0 = OFF_OB + PLANE;
constexpr size_t OFF_H1 = OFF_BIG;
constexpr size_t OFF_QB = OFF_H1 + (size_t)NB * TPB * D * 2;
constexpr size_t OFF_KB = OFF_QB + (size_t)GLAT * DI_ * 2;
constexpr size_t OFF_VT = OFF_KB + PLANE;
constexpr size_t OFF_GB = OFF_VT + PLANE;
constexpr size_t OFF_Y2 = OFF_GB + (size_t)GLAT * DI_ * 2;
constexpr size_t WS_NEED1 = OFF_Y2 + (size_t)GLAT * DI_ * 2;
constexpr size_t WS_NEED = WS_NEED0 > WS_NEED1 ? WS_NEED0 : WS_NEED1;
constexpr size_t HG_STRIDE = 67108864;

struct Params {
    const float *x, *c, *ctx, *c_ctx, *w_ada, *b_ada, *norm_g, *hg_w_in, *hg_lb, *hg_norm_g, *hg_w_out;
    const float *da_w_in, *lq1, *lk1, *lq2, *lk2, *subln_g, *da_w_out, *final_g;
    float* out;
    unsigned char* ws;
    int ph_begin, ph_end;
};

DI unsigned pk2(float a, float b) { f2_t v = {a, b}; bf2_t r = __builtin_convertvector(v, bf2_t); return __builtin_bit_cast(unsigned, r); }
DI float bf_lo(unsigned u) { return __uint_as_float(u << 16); }
DI float bf_hi(unsigned u) { return __uint_as_float(u & 0xffff0000u); }
DI float sigmoidf_(float z) { return __builtin_amdgcn_rcpf(1.0f + __builtin_amdgcn_exp2f(-1.4426950408889634f * z)); }
DI float siluf_(float z) { return z * __builtin_amdgcn_rcpf(1.0f + __builtin_amdgcn_exp2f(-1.4426950408889634f * z)); }
DI int opaque_tid() { int t = threadIdx.x; asm volatile("" : "+v"(t)); return t; }
template <int CTRL> DI float qperm(float v) { return __int_as_float(__builtin_amdgcn_mov_dpp(__float_as_int(v), CTRL, 0xF, 0xF, true)); }
DI float wave_sum(float v) {
#pragma unroll
    for (int o = 32; o >= 1; o >>= 1) v += __shfl_xor(v, o);
    return v;
}

DI int perm_row(int n, int mode) {
    if (mode == 0 || n >= 4096) return n;
    const int base = n & ~127, e = n & 127;
    const int p = e >> 6, a = (e >> 5) & 1, s2 = (e >> 4) & 1, i = e & 15;
    return base + 64 * p + 32 * a + 2 * i + s2;
}
__device__ void transpose_tile(const float* __restrict__ W, int K, int N, int tk, int tn, bf16_t* __restrict__ Wt, int mode, float* lds) {
    const int tid = opaque_tid();
    const int k0 = tk * 64, n0 = tn * 64;
#pragma unroll
    for (int i = 0; i < 1024 / NTH; ++i) {
        const int idx = tid + i * NTH, kr = idx >> 4, c4 = idx & 15;
        const float4 v = *(const float4*)(W + (size_t)(k0 + kr) * N + n0 + c4 * 4);
        float* d = lds + kr * 65 + c4 * 4;
        d[0] = v.x; d[1] = v.y; d[2] = v.z; d[3] = v.w;
    }
    __syncthreads();
    {
        const int idx = tid, nr = idx >> 3, kc = idx & 7;
        float f[8];
#pragma unroll
        for (int j = 0; j < 8; ++j) f[j] = lds[(kc * 8 + j) * 65 + nr];
        uint4 o; o.x = pk2(f[0], f[1]); o.y = pk2(f[2], f[3]); o.z = pk2(f[4], f[5]); o.w = pk2(f[6], f[7]);
        *(uint4*)(Wt + (size_t)perm_row(n0 + nr, mode) * K + k0 + kc * 8) = o;
    }
    __syncthreads();
}

__device__ void mod_item(const Params& p, int item, float* lds) {
    const int tid = opaque_tid(), lane = tid & 63, wave = tid >> 6;
    const int layer = item / 48, j = (item % 48) * 64 + lane;
    for (int idx = tid; idx < 9 * 1024; idx += NTH) {
        const int r = idx >> 10, k = idx & 1023;
        const float cv = r < 8 ? p.c[r * 1024 + k] : p.c_ctx[k];
        lds[idx] = siluf_(cv);
    }
    __syncthreads();
    float acc[9];
#pragma unroll
    for (int r = 0; r < 9; ++r) acc[r] = 0.f;
    const float* w = p.w_ada + (size_t)layer * 1024 * 3072 + (size_t)(wave * 128) * 3072 + j;
#pragma unroll 8
    for (int k = 0; k < 128; ++k) {
        const float wv = w[(size_t)k * 3072];
#pragma unroll
        for (int r = 0; r < 9; ++r) acc[r] += lds[r * 1024 + wave * 128 + k] * wv;
    }
    __syncthreads();
    float* part = lds + 9 * 1024;
#pragma unroll
    for (int r = 0; r < 9; ++r) part[(wave * 9 + r) * 64 + lane] = acc[r];
    __syncthreads();
    float* MOD = (float*)(p.ws + OFF_MOD);
    for (int idx = tid; idx < 9 * 64; idx += NTH) {
        const int r = idx >> 6, l = idx & 63, jj = (item % 48) * 64 + l;
        float sum = 0.f;
#pragma unroll
        for (int wv = 0; wv < 8; ++wv) sum += part[(wv * 9 + r) * 64 + l];
        MOD[(layer * 9 + r) * 3072 + jj] = sum + p.b_ada[layer * 3072 + jj];
    }
    __syncthreads();
}

__device__ void misc_item(const Params& p) {
    const int tid = opaque_tid();
    float* LB = (float*)(p.ws + OFF_LB);
    for (int idx = tid; idx < 2 * 2048; idx += NTH) {
        const float l0 = p.hg_lb[idx], l1 = p.hg_lb[2 * 2048 + idx];
        LB[idx] = 1.0f / (1.0f + __expf(l1 - l0));
    }
    if (tid == 0) {
        float s1 = 0.f, s2 = 0.f;
        for (int i = 0; i < 64; ++i) { s1 += p.lq1[i] * p.lk1[i]; s2 += p.lq2[i] * p.lk2[i]; }
        ((float*)(p.ws + OFF_SCAL))[0] = expf(s1) - expf(s2) + LAMBDA_INIT;
    }
}

__device__ void phase_prologue(const Params& p, float* lds) {
    const int n_items = 97 + 2560 + 512;
    for (int it = blockIdx.x; it < n_items; it += gridDim.x) {
        if (it < 96) mod_item(p, it, lds);
        else if (it == 96) misc_item(p);
        else if (it < 97 + 2560) { const int t = it - 97; transpose_tile(p.hg_w_in, 1024, 10240, t / 160, t % 160, (bf16_t*)(p.ws + OFF_WT_A), 0, lds); }
        else { const int t = it - 97 - 2560; transpose_tile(p.hg_w_out, 2048, 1024, t / 16, t % 16, (bf16_t*)(p.ws + OFF_WT_B), 0, lds); }
    }
}
__device__ void phase_convert_da(const Params& p, float* lds) {
    const int n_items = 2048 + 512;
    for (int it = blockIdx.x; it < n_items; it += gridDim.x) {
        if (it < 2048) transpose_tile(p.da_w_in, 1024, 8192, it / 128, it % 128, (bf16_t*)(p.ws + OFF_WT_A), 1, lds);
        else { const int t = it - 2048; transpose_tile(p.da_w_out, 2048, 1024, t / 16, t % 16, (bf16_t*)(p.ws + OFF_WT_B), 0, lds); }
    }
}

__device__ void phase_modulate(const Params& p, int layer, const float* lat, const float* ctxsrc, unsigned char* hbase, size_t hstride) {
    const int tid_ = opaque_tid(), lane = tid_ & 63, wave = tid_ >> 6;
    const float* MOD = (const float*)(p.ws + OFF_MOD);
    const float* g = p.norm_g + layer * 1024;
    for (int R = blockIdx.x * NWV + wave; R < NB * TPB; R += gridDim.x * NWV) {
        const int b = R / TPB, t = R % TPB;
        const float* src = t < CTX ? ctxsrc + ((size_t)b * CTX + t) * D : lat + ((size_t)b * SEQ + (t - CTX)) * D;
        const float* mrow = MOD + (size_t)(layer * 9 + (t < CTX ? 8 : b)) * 3072;
        float4 v[4];
        float ss = 0.f;
#pragma unroll
        for (int i = 0; i < 4; ++i) { v[i] = *(const float4*)(src + (i * 64 + lane) * 4); ss += v[i].x * v[i].x + v[i].y * v[i].y + v[i].z * v[i].z + v[i].w * v[i].w; }
        ss = wave_sum(ss);
        const float rstd = rsqrtf(ss * (1.0f / D) + EPS);
        bf16_t* dst = (bf16_t*)(hbase + (size_t)(b / GB_) * hstride) + ((size_t)(b % GB_) * TPB + t) * D;
#pragma unroll
        for (int i = 0; i < 4; ++i) {
            const int e = (i * 64 + lane) * 4;
            const float4 gg = *(const float4*)(g + e), sh = *(const float4*)(mrow + e), sc = *(const float4*)(mrow + 1024 + e);
            const float h0 = v[i].x * rstd * gg.x * (1.f + sc.x) + sh.x, h1 = v[i].y * rstd * gg.y * (1.f + sc.y) + sh.y;
            const float h2 = v[i].z * rstd * gg.z * (1.f + sc.z) + sh.z, h3 = v[i].w * rstd * gg.w * (1.f + sc.w) + sh.w;
            uint2 o; o.x = pk2(h0, h1); o.y = pk2(h2, h3);
            *(uint2*)(dst + e) = o;
        }
    }
}

#define WAIT_VM0() asm volatile("s_waitcnt vmcnt(0)" ::: "memory")
constexpr int G_ABYTES = 256 * 128, G_BBYTES = 128 * 128, G_STAGEB = G_ABYTES + G_BBYTES;
DI void gemm_issue(const bf16_t* ga, const bf16_t* gb, int K, unsigned char* __restrict__ dst, int wave) {
#pragma unroll
    for (int i = 0; i < 4; ++i) __builtin_amdgcn_global_load_lds((const unsigned*)(ga + (size_t)i * 64 * K), (unsigned*)(dst + (i * 8 + wave) * 1024), 16, 0, 0);
#pragma unroll
    for (int i = 0; i < 2; ++i) __builtin_amdgcn_global_load_lds((const unsigned*)(gb + (size_t)i * 64 * K), (unsigned*)(dst + G_ABYTES + (i * 8 + wave) * 1024), 16, 0, 0);
}
DI void gemm_data(const unsigned char* __restrict__ sA, unsigned char* __restrict__ dNext, bool issue, const bf16_t* ga2, const bf16_t* gb2, int K, int wave,
                  int wm, int wn, int fr, int fq, int rsw, bf16x8 (&af)[2][4], bf16x8 (&bfr)[2][4]) {
    const unsigned char* sB = sA + G_ABYTES;
#pragma unroll
    for (int ks = 0; ks < 2; ++ks)
#pragma unroll
        for (int i = 0; i < 4; ++i) {
            af[ks][i] = *(const bf16x8*)(sA + (wm * 64 + i * 16 + fr) * 128 + ((ks * 4 + fq) ^ rsw) * 16);
            bfr[ks][i] = *(const bf16x8*)(sB + (wn * 64 + i * 16 + fr) * 128 + ((ks * 4 + fq) ^ rsw) * 16);
        }
    __builtin_amdgcn_sched_barrier(0);
    if (issue) gemm_issue(ga2, gb2, K, dNext, wave);
}
DI void gemm_mfma(const bf16x8 (&af)[2][4], const bf16x8 (&bfr)[2][4], bool swapped, f32x4 (&acc)[4][4]) {
#pragma unroll
    for (int ks = 0; ks < 2; ++ks) {
        if (!swapped) {
#pragma unroll
            for (int i = 0; i < 4; ++i)
#pragma unroll
                for (int j = 0; j < 4; ++j) acc[i][j] = __builtin_amdgcn_mfma_f32_16x16x32_bf16(bfr[ks][j], af[ks][i], acc[i][j], 0, 0, 0);
        } else {
#pragma unroll
            for (int i = 0; i < 4; ++i)
#pragma unroll
                for (int j = 0; j < 4; ++j) acc[i][j] = __builtin_amdgcn_mfma_f32_16x16x32_bf16(af[ks][i], bfr[ks][j], acc[i][j], 0, 0, 0);
        }
    }
}
template <int HALF>
DI void gemm_kloop(unsigned char* lds, int& stg, int KT, bool have_next, const bf16_t* ga, const bf16_t* gb, const bf16_t* ga1, const bf16_t* gb1, int K, int wave,
                   int wm, int wn, int fr, int fq, int rsw, bool swapped, f32x4 (&acc)[4][4]) {
    for (int kt = 0; kt < KT; ++kt) {
        bf16x8 af[2][4], bfr[2][4];
        const int s3 = stg >= 1 ? stg - 1 : 2;
        const bool in_tile = kt + 2 < KT, issue = in_tile || have_next;
        const bf16_t* pa = in_tile ? ga + (kt + 2) * 64 : ga1 + (kt + 2 - KT) * 64;
        const bf16_t* pb = in_tile ? gb + (kt + 2) * 64 : gb1 + (kt + 2 - KT) * 64;
        if (HALF == 0) {
            gemm_data(lds + stg * G_STAGEB, lds + s3 * G_STAGEB, issue, pa, pb, K, wave, wm, wn, fr, fq, rsw, af, bfr);
            asm volatile("s_waitcnt lgkmcnt(0)" ::: "memory");
            __builtin_amdgcn_s_barrier();
            gemm_mfma(af, bfr, swapped, acc);
            if (issue) asm volatile("s_waitcnt vmcnt(6)" ::: "memory"); else asm volatile("s_waitcnt vmcnt(0)" ::: "memory");
            __builtin_amdgcn_s_barrier();
        } else {
            __builtin_amdgcn_s_barrier();
            gemm_data(lds + stg * G_STAGEB, lds + s3 * G_STAGEB, issue, pa, pb, K, wave, wm, wn, fr, fq, rsw, af, bfr);
            if (issue) asm volatile("s_waitcnt vmcnt(6)" ::: "memory"); else asm volatile("s_waitcnt vmcnt(0)" ::: "memory");
            asm volatile("s_waitcnt lgkmcnt(0)" ::: "memory");
            __builtin_amdgcn_s_barrier();
            gemm_mfma(af, bfr, swapped, acc);
        }
        stg = stg == 2 ? 0 : stg + 1;
    }
}
struct TileCur { int st, tt; };
template <class Epi>
DI bool gemm_next_tile(TileCur& c, int& m0, int& n0, const Epi& epi, int SNn, int nsuper, int lb, int nl) {
    for (;;) {
        if (c.st >= nsuper) return false;
        const int sm = c.st / SNn, sn = c.st % SNn;
        m0 = (sm * 4 + (c.tt & 3)) * 256; n0 = (sn * 8 + (c.tt >> 2)) * 128;
        c.tt += nl;
        if (c.tt >= 32) { c.tt = lb; c.st += 8; }
        if (!epi.skip(m0, n0)) return true;
    }
}
template <class Epi>
__device__ void gemm_phase(const bf16_t* __restrict__ A, const bf16_t* __restrict__ Bt, int M, int N, int K, const Epi& epi, unsigned char* lds) {
    const int tid = opaque_tid(), lane = tid & 63, wave = __builtin_amdgcn_readfirstlane(tid >> 6), wm = wave >> 1, wn = wave & 1;
    const int fr = lane & 15, fq = lane >> 4;
    const int MT = M / 256, NT = N / 128, SMn = MT / 4, SNn = NT / 8, nsuper = SMn * SNn;
    const int xcd = blockIdx.x & 7, lb = blockIdx.x >> 3, nl = gridDim.x >> 3;
    const int KT = K / 64;
    const int rl = wave * 8 + (lane >> 3), lchunk = (lane & 7) ^ ((rl >> 1) & 7);
    const int rsw = (fr >> 1) & 7;
    TileCur cur{xcd, lb};
    int m0, n0, m1 = 0, n1 = 0;
    bool have = gemm_next_tile(cur, m0, n0, epi, SNn, nsuper, lb, nl);
    WAIT_VM0();
    __syncthreads();
    int stg = 0;
    if (have) {
        const bf16_t* ga = A + (size_t)(m0 + rl) * K + lchunk * 8;
        const bf16_t* gb = Bt + (size_t)(n0 + rl) * K + lchunk * 8;
        gemm_issue(ga, gb, K, lds, wave);
        gemm_issue(ga + 64, gb + 64, K, lds + G_STAGEB, wave);
        asm volatile("s_waitcnt vmcnt(6)" ::: "memory");
    }
    __syncthreads();
    const int half = wave >> 2;
    if (half) __builtin_amdgcn_s_setprio(1);
    while (have) {
        const bool have_next = gemm_next_tile(cur, m1, n1, epi, SNn, nsuper, lb, nl);
        const bool swapped = epi.swapped(n0);
        f32x4 acc[4][4];
#pragma unroll
        for (int i = 0; i < 4; ++i)
#pragma unroll
            for (int j = 0; j < 4; ++j) acc[i][j] = (f32x4){0.f, 0.f, 0.f, 0.f};
        const bf16_t* ga = A + (size_t)(m0 + rl) * K + lchunk * 8;
        const bf16_t* gb = Bt + (size_t)(n0 + rl) * K + lchunk * 8;
        const bf16_t* ga1 = A + (size_t)(m1 + rl) * K + lchunk * 8;
        const bf16_t* gb1 = Bt + (size_t)(n1 + rl) * K + lchunk * 8;
        if (half == 0) gemm_kloop<0>(lds, stg, KT, have_next, ga, gb, ga1, gb1, K, wave, wm, wn, fr, fq, rsw, swapped, acc);
        else gemm_kloop<1>(lds, stg, KT, have_next, ga, gb, ga1, gb1, K, wave, wm, wn, fr, fq, rsw, swapped, acc);
#pragma unroll
        for (int i = 0; i < 4; ++i)
#pragma unroll
            for (int j = 0; j < 4; ++j) epi.store(m0 + wm * 64 + i * 16, n0 + wn * 64 + j * 16, acc[i][j], fr, fq);
        m0 = m1; n0 = n1; have = have_next;
    }
    __builtin_amdgcn_s_setprio(0);
    WAIT_VM0();
    __syncthreads();
}


constexpr int H_ABYTES = 256 * 64, H_STAGEB = 2 * H_ABYTES;
DI void gemmh_issue(const bf16_t* ga, const bf16_t* gb, int K, unsigned char* __restrict__ dst, int wave) {
#pragma unroll
    for (int i = 0; i < 2; ++i) {
        __builtin_amdgcn_global_load_lds((const unsigned*)(ga + (size_t)i * 128 * K), (unsigned*)(dst + (i * 8 + wave) * 1024), 16, 0, 0);
        __builtin_amdgcn_global_load_lds((const unsigned*)(gb + (size_t)i * 128 * K), (unsigned*)(dst + H_ABYTES + (i * 8 + wave) * 1024), 16, 0, 0);
    }
}
DI void gemmh_data(const unsigned char* __restrict__ sA, unsigned char* __restrict__ dNext, bool issue, const bf16_t* ga2, const bf16_t* gb2, int K, int wave,
                   int wm, int wn, int fr, int rpos, bf16x8 (&af)[8], bf16x8 (&bfr)[4]) {
    const unsigned char* sB = sA + H_ABYTES;
#pragma unroll
    for (int i = 0; i < 8; ++i) af[i] = *(const bf16x8*)(sA + (wm * 128 + i * 16 + fr) * 64 + rpos);
#pragma unroll
    for (int j = 0; j < 4; ++j) bfr[j] = *(const bf16x8*)(sB + (wn * 64 + j * 16 + fr) * 64 + rpos);
    __builtin_amdgcn_sched_barrier(0);
    if (issue) gemmh_issue(ga2, gb2, K, dNext, wave);
}
template <bool SW>
DI void gemmh_mfma(const bf16x8 (&af)[8], const bf16x8 (&bfr)[4], f32x4 (&acc)[8][4]) {
    if (!SW) {
#pragma unroll
        for (int i = 0; i < 8; ++i)
#pragma unroll
            for (int j = 0; j < 4; ++j) acc[i][j] = __builtin_amdgcn_mfma_f32_16x16x32_bf16(bfr[j], af[i], acc[i][j], 0, 0, 0);
    } else {
#pragma unroll
        for (int i = 0; i < 8; ++i)
#pragma unroll
            for (int j = 0; j < 4; ++j) acc[i][j] = __builtin_amdgcn_mfma_f32_16x16x32_bf16(af[i], bfr[j], acc[i][j], 0, 0, 0);
    }
}
template <int HALF, bool SW>
DI void gemmh_kloop(unsigned char* lds, int& stg, int KT, bool have_next, const bf16_t* ga, const bf16_t* gb, const bf16_t* ga1, const bf16_t* gb1, int K, int wave,
                    int wm, int wn, int fr, int rpos, f32x4 (&acc)[8][4]) {
    for (int kt = 0; kt < KT; ++kt) {
        bf16x8 af[8], bfr[4];
        const int s3 = stg >= 1 ? stg - 1 : 2;
        const bool in_tile = kt + 2 < KT, issue = in_tile || have_next;
        const bf16_t* pa = in_tile ? ga + (kt + 2) * 32 : ga1 + (kt + 2 - KT) * 32;
        const bf16_t* pb = in_tile ? gb + (kt + 2) * 32 : gb1 + (kt + 2 - KT) * 32;
        if (HALF == 0) {
            gemmh_data(lds + stg * H_STAGEB, lds + s3 * H_STAGEB, issue, pa, pb, K, wave, wm, wn, fr, rpos, af, bfr);
            asm volatile("s_waitcnt lgkmcnt(0)" ::: "memory");
            __builtin_amdgcn_s_barrier();
            gemmh_mfma<SW>(af, bfr, acc);
            if (issue) asm volatile("s_waitcnt vmcnt(4)" ::: "memory"); else asm volatile("s_waitcnt vmcnt(0)" ::: "memory");
            __builtin_amdgcn_s_barrier();
        } else {
            __builtin_amdgcn_s_barrier();
            gemmh_data(lds + stg * H_STAGEB, lds + s3 * H_STAGEB, issue, pa, pb, K, wave, wm, wn, fr, rpos, af, bfr);
            if (issue) asm volatile("s_waitcnt vmcnt(4)" ::: "memory"); else asm volatile("s_waitcnt vmcnt(0)" ::: "memory");
            asm volatile("s_waitcnt lgkmcnt(0)" ::: "memory");
            __builtin_amdgcn_s_barrier();
            gemmh_mfma<SW>(af, bfr, acc);
        }
        stg = stg == 2 ? 0 : stg + 1;
    }
}
template <class Epi>
DI bool gemmh_next_tile(TileCur& c, int& m0, int& n0, const Epi& epi, int SNn, int nsuper, int lb, int nl) {
    for (;;) {
        if (c.st >= nsuper) return false;
        const int sm = c.st / SNn, sn = c.st % SNn;
        m0 = (sm * 4 + (c.tt & 3)) * 256; n0 = (sn * 8 + (c.tt >> 2)) * 256;
        c.tt += nl;
        if (c.tt >= 32) { c.tt = lb; c.st += 8; }
        if (!epi.skip(m0, n0)) return true;
    }
}
template <class Epi>
__device__ void gemmh_phase(const bf16_t* __restrict__ A, const bf16_t* __restrict__ Bt, int M, int N, int K, const Epi& epi, unsigned char* lds) {
    const int tid = opaque_tid(), lane = tid & 63, wave = __builtin_amdgcn_readfirstlane(tid >> 6), wm = wave >> 2, wn = wave & 3;
    const int fr = lane & 15, fq = lane >> 4;
    const int MT = M / 256, NT = N / 256, SMn = MT / 4, SNn = NT / 8, nsuper = SMn * SNn;
    const int xcd = blockIdx.x & 7, lb = blockIdx.x >> 3, nl = gridDim.x >> 3;
    const int KT = K / 32;
    const int rl = wave * 16 + (lane >> 2), lchunk = (lane & 3) ^ ((0 - (lane >> 4)) & 3);
    const int rpos = (fq ^ ((0 - (fr >> 2)) & 3)) << 4;
    TileCur cur{xcd, lb};
    int m0, n0, m1 = 0, n1 = 0;
    bool have = gemmh_next_tile(cur, m0, n0, epi, SNn, nsuper, lb, nl);
    WAIT_VM0();
    __syncthreads();
    int stg = 0;
    if (have) {
        const bf16_t* ga = A + (size_t)(m0 + rl) * K + lchunk * 8;
        const bf16_t* gb = Bt + (size_t)(n0 + rl) * K + lchunk * 8;
        gemmh_issue(ga, gb, K, lds, wave);
        gemmh_issue(ga + 32, gb + 32, K, lds + H_STAGEB, wave);
        asm volatile("s_waitcnt vmcnt(4)" ::: "memory");
    }
    __syncthreads();
    const int half = wave >> 2;
    if (half) __builtin_amdgcn_s_setprio(1);
    while (have) {
        const bool have_next = gemmh_next_tile(cur, m1, n1, epi, SNn, nsuper, lb, nl);
        const bool swapped = epi.swapped(n0);
        f32x4 acc[8][4];
#pragma unroll
        for (int i = 0; i < 8; ++i)
#pragma unroll
            for (int j = 0; j < 4; ++j) acc[i][j] = (f32x4){0.f, 0.f, 0.f, 0.f};
        const bf16_t* ga = A + (size_t)(m0 + rl) * K + lchunk * 8;
        const bf16_t* gb = Bt + (size_t)(n0 + rl) * K + lchunk * 8;
        const bf16_t* ga1 = A + (size_t)(m1 + rl) * K + lchunk * 8;
        const bf16_t* gb1 = Bt + (size_t)(n1 + rl) * K + lchunk * 8;
        if (!swapped) {
            if (half == 0) gemmh_kloop<0, false>(lds, stg, KT, have_next, ga, gb, ga1, gb1, K, wave, wm, wn, fr, rpos, acc);
            else gemmh_kloop<1, false>(lds, stg, KT, have_next, ga, gb, ga1, gb1, K, wave, wm, wn, fr, rpos, acc);
        } else {
            if (half == 0) gemmh_kloop<0, true>(lds, stg, KT, have_next, ga, gb, ga1, gb1, K, wave, wm, wn, fr, rpos, acc);
            else gemmh_kloop<1, true>(lds, stg, KT, have_next, ga, gb, ga1, gb1, K, wave, wm, wn, fr, rpos, acc);
        }
#pragma unroll
        for (int i = 0; i < 8; ++i)
#pragma unroll
            for (int j = 0; j < 4; j += 2) epi.store2(m0 + wm * 128 + i * 16, n0 + wn * 64 + j * 16, acc[i][j], acc[i][j + 1], fr, fq);
        m0 = m1; n0 = n1; have = have_next;
    }
    __builtin_amdgcn_s_setprio(0);
    WAIT_VM0();
    __syncthreads();
}

struct EpiPlanes {
    bf16_t* P; const float* LB;
    DI bool skip(int, int) const { return false; }
    DI bool swapped(int) const { return false; }
    DI uint2 act(int n, const f32x4& a) const {
        const int pl = n >> 11, c = n & 2047;
        float v0 = a[0], v1 = a[1], v2 = a[2], v3 = a[3];
        if (pl == 0 || pl == 4) { v0 = siluf_(v0); v1 = siluf_(v1); v2 = siluf_(v2); v3 = siluf_(v3); }
        else if (pl != 3) {
            const f32x4 lb = *(const f32x4*)(LB + (pl - 1) * 2048 + c);
            v0 = 0.6931471805599453f * __builtin_amdgcn_logf(lb[0] + (1.f - lb[0]) * sigmoidf_(v0)); v1 = 0.6931471805599453f * __builtin_amdgcn_logf(lb[1] + (1.f - lb[1]) * sigmoidf_(v1));
            v2 = 0.6931471805599453f * __builtin_amdgcn_logf(lb[2] + (1.f - lb[2]) * sigmoidf_(v2)); v3 = 0.6931471805599453f * __builtin_amdgcn_logf(lb[3] + (1.f - lb[3]) * sigmoidf_(v3));
        }
        uint2 o; o.x = pk2(v0, v1); o.y = pk2(v2, v3);
        return o;
    }
    DI void store(int mb, int nb, const f32x4& a, int fr, int fq) const {
        const int row = mb + fr, n = nb + fq * 4, pl = n >> 11, c = n & 2047;
        *(uint2*)(P + ((size_t)pl * GROWS + row) * DI_ + c) = act(n, a);
    }
    DI void store2(int mb, int nb, const f32x4& a, const f32x4& b, int fr, int fq) const {
        const uint2 oa = act(nb + fq * 4, a), ob = act(nb + 16 + fq * 4, b);
        const bool odd = fq & 1;
        typedef unsigned u2v __attribute__((ext_vector_type(2)));
        const u2v px = __builtin_amdgcn_permlane16_swap(oa.x, ob.x, false, false), py = __builtin_amdgcn_permlane16_swap(oa.y, ob.y, false, false);
        uint4 o; o.x = px.x; o.y = py.x; o.z = px.y; o.w = py.y;
        const int row = mb + fr, n = nb + (odd ? 16 : 0) + (fq & ~1) * 4, pl = n >> 11, c = n & 2047;
        *(uint4*)(P + ((size_t)pl * GROWS + row) * DI_ + c) = o;
    }
};
struct EpiOut0 {
    const float *x, *ctx, *MOD0; float *out, *x1ctx; int g;
    DI bool skip(int, int) const { return false; }
    DI bool swapped(int) const { return false; }
    DI void store(int mb, int nb, const f32x4& a, int fr, int fq) const {
        const int row = mb + fr, n = nb + fq * 4;
        const int b = g * GB_ + row / TPB, t = row % TPB;
        const bool isctx = t < CTX;
        const f32x4 gt = *(const f32x4*)(MOD0 + (size_t)(isctx ? 8 : b) * 3072 + 2048 + n);
        const size_t idx = isctx ? ((size_t)b * CTX + t) * D + n : ((size_t)b * SEQ + (t - CTX)) * D + n;
        const f32x4 xi = *(const f32x4*)((isctx ? ctx : x) + idx);
        *(f32x4*)((isctx ? x1ctx : out) + idx) = xi + gt * a;
    }
};
struct EpiOut1 {
    const float* MOD1; float* out; int g;
    DI bool skip(int, int) const { return false; }
    DI bool swapped(int) const { return false; }
    DI void store(int mb, int nb, const f32x4& a, int fr, int fq) const {
        const int row = mb + fr, n = nb + fq * 4;
        const int b = g * GB_ + row / SEQ;
        const f32x4 gt = *(const f32x4*)(MOD1 + (size_t)b * 3072 + 2048 + n);
        float* o = out + ((size_t)g * GLAT + row) * D + n;
        *(f32x4*)o = *(const f32x4*)o + gt * a;
    }
};
struct EpiDA {
    bf16_t *Q, *Kb, *Vt, *G;
    DI bool skip(int m0, int n0) const { const int sec = n0 >> 11; return (sec == 0 || sec == 3) && (m0 % TPB) < CTX; }
    DI bool swapped(int n0) const { return (n0 >> 11) == 2; }
    DI uint2 val(int sec, int t, int c, const f32x4& a) const {
        float v0 = a[0], v1 = a[1], v2 = a[2], v3 = a[3];
        if (sec <= 1 && t >= CTX) {
            const int l = t - CTX, ep = c & 127, ax = (ep >> 5) & 1, i0 = (ep & 31) >> 1;
            const float pos = (float)(ax ? (l & 63) : (l >> 6));
            const float a0 = pos * __builtin_amdgcn_exp2f(-0.83048202372184f * (float)i0), a1 = pos * __builtin_amdgcn_exp2f(-0.83048202372184f * (float)(i0 + 1));
            const float c0 = __cosf(a0), s0 = __sinf(a0), c1 = __cosf(a1), s1 = __sinf(a1);
            const float r0 = v0 * c0 - v1 * s0, r1 = v1 * c0 + v0 * s0, r2 = v2 * c1 - v3 * s1, r3 = v3 * c1 + v2 * s1;
            v0 = r0; v1 = r1; v2 = r2; v3 = r3;
        }
        if (sec == 0) { v0 *= QSCALE; v1 *= QSCALE; v2 *= QSCALE; v3 *= QSCALE; }
        uint2 o; o.x = pk2(v0, v1); o.y = pk2(v2, v3);
        return o;
    }
    DI bf16_t* dst(int sec, int row, int bl, int t, int c) const {
        if (sec == 1) return Kb + (size_t)row * DI_ + c;
        return (sec == 0 ? Q : G) + ((size_t)bl * SEQ + (t - CTX)) * DI_ + c;
    }
    DI void store(int mb, int nb, const f32x4& a, int fr, int fq) const {
        const int sec = nb >> 11;
        if (sec == 2) {
            const int row = mb + fq * 4, bl = row / TPB, t = row % TPB, c = (nb & 2047) + fr, hd = c >> 7, e = c & 127;
            uint2 o; o.x = pk2(a[0], a[1]); o.y = pk2(a[2], a[3]);
            *(uint2*)(Vt + ((size_t)(bl * NH + hd) * 128 + e) * TPB + t) = o;
            return;
        }
        const int row = mb + fr, bl = row / TPB, t = row % TPB, c = (nb & 2047) + fq * 4;
        *(uint2*)dst(sec, row, bl, t, c) = val(sec, t, c, a);
    }
    DI void store2(int mb, int nb, const f32x4& a, const f32x4& b, int fr, int fq) const {
        const int sec = nb >> 11;
        const bool odd = fq & 1;
        uint2 oa, ob;
        if (sec == 2) { oa.x = pk2(a[0], a[1]); oa.y = pk2(a[2], a[3]); ob.x = pk2(b[0], b[1]); ob.y = pk2(b[2], b[3]); }
        else {
            const int t = (mb + fr) % TPB, c = (nb & 2047) + fq * 4;
            oa = val(sec, t, c, a); ob = val(sec, t, c + 16, b);
        }
        typedef unsigned u2v __attribute__((ext_vector_type(2)));
        const u2v px = __builtin_amdgcn_permlane16_swap(oa.x, ob.x, false, false), py = __builtin_amdgcn_permlane16_swap(oa.y, ob.y, false, false);
        uint4 o; o.x = px.x; o.y = py.x; o.z = px.y; o.w = py.y;
        if (sec == 2) {
            const int row = mb + (fq & ~1) * 4, bl = row / TPB, t = row % TPB, c = (nb & 2047) + (odd ? 16 : 0) + fr, hd = c >> 7, e = c & 127;
            *(uint4*)(Vt + ((size_t)(bl * NH + hd) * 128 + e) * TPB + t) = o;
            return;
        }
        const int row = mb + fr, bl = row / TPB, t = row % TPB, c = (nb & 2047) + (odd ? 16 : 0) + (fq & ~1) * 4;
        *(uint4*)dst(sec, row, bl, t, c) = o;
    }
};

constexpr int SC_RAWQ = 0, SC_RAWZ = 8320, SC_RAWV = 16640, SC_RAWSTG = 20992;
constexpr int SC_QE = 2 * SC_RAWSTG, SC_KE = SC_QE + 8192, SC_KDT = SC_KE + 8192, SC_VT = SC_KDT + 8192, SC_ER = SC_VT + 4096, SC_EB = SC_ER + 512, SC_YI = SC_EB + 512;
DI int scan_tok(int n, int dir) { return dir == 0 ? n : (n < CTX ? CTX - 1 - n : (TPB + CTX - 1) - n); }
__device__ void phase_scan(const Params& p, unsigned char* lds) {
    const int tid = opaque_tid(), lane = tid & 63, wave = __builtin_amdgcn_readfirstlane(tid >> 6), r = lane & 31, h = lane >> 5;
    const int c = tid >> 2, tq = tid & 3;
    const int pc = (c & ~12) | ((c & 4) << 1) | ((c & 8) >> 1);
    const bf16_t* P1 = (const bf16_t*)(p.ws + OFF_P1);
    for (int u = blockIdx.x; u < 256; u += gridDim.x) {
        const int vh = (u >> 3) & 1, sidx = (u >> 4) * 8 + (u & 7), dir = sidx & 1, hd = (sidx >> 1) & 15, bl = sidx >> 5;
        bf16_t* Od = (bf16_t*)(p.ws + (dir ? OFF_OB : OFF_OF));
        const bf16_t* gq = P1 + hd * 128 + (lane & 15) * 8;
        const bf16_t* gz = P1 + (size_t)(1 + dir) * GROWS * DI_ + hd * 128 + (lane & 15) * 8;
        const bf16_t* gvv = P1 + (size_t)3 * GROWS * DI_ + hd * 128 + vh * 64 + (lane & 7) * 8;
        f32x16 S[4];
#pragma unroll
        for (int i = 0; i < 4; ++i)
#pragma unroll
            for (int j = 0; j < 16; ++j) S[i][j] = 0.f;
        WAIT_VM0();
        {
            const size_t rq = (size_t)bl * TPB + scan_tok(4 * wave + (lane >> 4), dir);
            __builtin_amdgcn_global_load_lds((const unsigned*)(gq + rq * DI_), (unsigned*)(lds + SC_RAWQ + wave * 1040), 16, 0, 0);
            __builtin_amdgcn_global_load_lds((const unsigned*)(gz + rq * DI_), (unsigned*)(lds + SC_RAWZ + wave * 1040), 16, 0, 0);
            if (wave < 4) {
                const size_t rv = (size_t)bl * TPB + scan_tok(8 * wave + (lane >> 3), dir);
                __builtin_amdgcn_global_load_lds((const unsigned*)(gvv + rv * DI_), (unsigned*)(lds + SC_RAWV + wave * 1056), 16, 0, 0);
            }
        }
        WAIT_VM0();
        __syncthreads();
        constexpr int NCH = TPB / 32;
        f32x16 Ykeep;
#pragma unroll
        for (int j = 0; j < 16; ++j) Ykeep[j] = 0.f;
        for (int n = 0; n < NCH; ++n) {
            const unsigned char* raw = lds + (n & 1) * SC_RAWSTG;
            if (n + 1 < NCH) {
                unsigned char* nxt = lds + ((n + 1) & 1) * SC_RAWSTG;
                const size_t rq = (size_t)bl * TPB + scan_tok((n + 1) * 32 + 4 * wave + (lane >> 4), dir);
                __builtin_amdgcn_global_load_lds((const unsigned*)(gq + rq * DI_), (unsigned*)(nxt + SC_RAWQ + wave * 1040), 16, 0, 0);
                __builtin_amdgcn_global_load_lds((const unsigned*)(gz + rq * DI_), (unsigned*)(nxt + SC_RAWZ + wave * 1040), 16, 0, 0);
                if (wave < 4) {
                    const size_t rv = (size_t)bl * TPB + scan_tok((n + 1) * 32 + 8 * wave + (lane >> 3), dir);
                    __builtin_amdgcn_global_load_lds((const unsigned*)(gvv + rv * DI_), (unsigned*)(nxt + SC_RAWV + wave * 1056), 16, 0, 0);
                }
            }
            if (wave < 2 && n > 0) {
                const size_t orow = (size_t)bl * TPB + scan_tok((n - 1) * 32 + r, dir);
                bf16_t* op = Od + orow * DI_ + hd * 128 + vh * 64 + wave * 32 + 4 * h;
#pragma unroll
                for (int g4 = 0; g4 < 4; ++g4) {
                    const float* yi = (const float*)(lds + SC_YI) + (wave * 16 + 4 * g4) * 64 + lane;
                    uint2 o; o.x = pk2(Ykeep[4 * g4] + yi[0], Ykeep[4 * g4 + 1] + yi[64]); o.y = pk2(Ykeep[4 * g4 + 2] + yi[128], Ykeep[4 * g4 + 3] + yi[192]);
                    *(uint2*)(op + 8 * g4) = o; }
            }
            {
                float b[8], kk[8], qs[8];
                float run = 0.f;
#pragma unroll
                for (int i = 0; i < 8; ++i) {
                    const int t = tq * 8 + i, off = (t >> 2) * 1040 + (t & 3) * 256 + c * 2;
                    const float g = __uint_as_float((unsigned)(*(const bf16_t*)(raw + SC_RAWZ + off)) << 16);
                    const float qv = __uint_as_float((unsigned)(*(const bf16_t*)(raw + SC_RAWQ + off)) << 16);
                    run += g; b[i] = run; kk[i] = 1.f - __expf(g); qs[i] = qv;
                }
                float x = run, y = qperm<0x90>(x);
                if (tq >= 1) x += y;
                y = qperm<0x44>(x);
                if (tq >= 2) x += y;
                const float excl = x - run;
                const float Btot = qperm<0xFF>(x);
                const float b7 = b[7] + excl;
                const float rho = qperm<0x55>(b7);
                const float eBr = __expf(Btot - rho);
                unsigned kd[4];
                float kdprev = 0.f;
#pragma unroll
                for (int i = 0; i < 8; ++i) {
                    const int t = tq * 8 + i;
                    const float d = b[i] + excl - rho;
                    const float ea = __expf(d), eb = __builtin_amdgcn_rcpf(ea);
                    const float qe = qs[i] * ea, ke = kk[i] * eb, kdv = ke * eBr;
                    const int addr = t * 256 + (((pc >> 3) ^ (t & 15)) << 4) + (pc & 7) * 2;
                    *(bf16_t*)(lds + SC_QE + addr) = (bf16_t)(pk2(qe, 0.f) & 0xffffu);
                    *(bf16_t*)(lds + SC_KE + addr) = (bf16_t)(pk2(ke, 0.f) & 0xffffu);
                    if (i & 1) kd[i >> 1] = pk2(kdprev, kdv); else kdprev = kdv;
                }
                uint4 kdw; kdw.x = kd[0]; kdw.y = kd[1]; kdw.z = kd[2]; kdw.w = kd[3];
                *(uint4*)(lds + SC_KDT + c * 64 + ((tq ^ ((c >> 2) & 3)) << 4)) = kdw;
                if (tq == 0) { *(float*)(lds + SC_ER + c * 4) = __expf(rho); *(float*)(lds + SC_EB + c * 4) = __expf(Btot); }
                if (tid < 256) {
                    const int dv = c;
                    unsigned short vv[8];
#pragma unroll
                    for (int i = 0; i < 8; ++i) vv[i] = *(const bf16_t*)(raw + SC_RAWV + tq * 1056 + i * 128 + dv * 2);
                    uint4 w; w.x = vv[0] | ((unsigned)vv[1] << 16); w.y = vv[2] | ((unsigned)vv[3] << 16); w.z = vv[4] | ((unsigned)vv[5] << 16); w.w = vv[6] | ((unsigned)vv[7] << 16);
                    *(uint4*)(lds + SC_VT + dv * 64 + ((tq ^ ((dv >> 2) & 3)) << 4)) = w;
                }
            }
            __syncthreads();
            if (wave < 2) {
                const int dvb = wave, sw4 = (r >> 2) & 3;
                const unsigned char* qrow = lds + SC_QE + r * 256;
                const unsigned char* vrow = lds + SC_VT + (dvb * 32 + r) * 64;
                bf16x8 qf[8];
#pragma unroll
                for (int k8 = 0; k8 < 8; ++k8) qf[k8] = *(const bf16x8*)(qrow + (((2 * k8 + h) ^ (r & 15)) << 4));
                f32x16 Y, Y2;
#pragma unroll
                for (int j = 0; j < 16; ++j) { Y[j] = 0.f; Y2[j] = 0.f; }
#pragma unroll
                for (int dkb = 0; dkb < 4; ++dkb) {
                    f32x4 er[4];
#pragma unroll
                    for (int g4 = 0; g4 < 4; ++g4) er[g4] = *(const f32x4*)(lds + SC_ER + (dkb * 32 + 8 * g4 + 4 * h) * 4);
                    unsigned pkd[8];
#pragma unroll
                    for (int g4 = 0; g4 < 4; ++g4) {
                        pkd[2 * g4] = pk2(S[dkb][4 * g4] * er[g4][0], S[dkb][4 * g4 + 1] * er[g4][1]);
                        pkd[2 * g4 + 1] = pk2(S[dkb][4 * g4 + 2] * er[g4][2], S[dkb][4 * g4 + 3] * er[g4][3]);
                    }
                    typedef unsigned u4 __attribute__((ext_vector_type(4)));
                    const u4 t0 = {pkd[0], pkd[1], pkd[2], pkd[3]}, t1 = {pkd[4], pkd[5], pkd[6], pkd[7]};
                    Y = __builtin_amdgcn_mfma_f32_32x32x16_bf16(__builtin_bit_cast(bf16x8, t0), qf[dkb * 2], Y, 0, 0, 0);
                    Y2 = __builtin_amdgcn_mfma_f32_32x32x16_bf16(__builtin_bit_cast(bf16x8, t1), qf[dkb * 2 + 1], Y2, 0, 0, 0);
                }
#pragma unroll
                for (int j = 0; j < 16; ++j) Ykeep[j] = Y[j] + Y2[j];
                bf16x8 kdf[8], vf2[2];
#pragma unroll
                for (int dkb = 0; dkb < 4; ++dkb)
#pragma unroll
                    for (int s2 = 0; s2 < 2; ++s2) kdf[dkb * 2 + s2] = *(const bf16x8*)(lds + SC_KDT + (dkb * 32 + r) * 64 + (((2 * s2 + h) ^ sw4) << 4));
#pragma unroll
                for (int s2 = 0; s2 < 2; ++s2) vf2[s2] = *(const bf16x8*)(vrow + (((2 * s2 + h) ^ sw4) << 4));
#pragma unroll
                for (int dkb = 0; dkb < 4; ++dkb) {
                    f32x4 eb[4];
#pragma unroll
                    for (int g4 = 0; g4 < 4; ++g4) eb[g4] = *(const f32x4*)(lds + SC_EB + (dkb * 32 + 8 * g4 + 4 * h) * 4);
#pragma unroll
                    for (int g4 = 0; g4 < 4; ++g4) { S[dkb][4 * g4] *= eb[g4][0]; S[dkb][4 * g4 + 1] *= eb[g4][1]; S[dkb][4 * g4 + 2] *= eb[g4][2]; S[dkb][4 * g4 + 3] *= eb[g4][3]; }
#pragma unroll
                    for (int s2 = 0; s2 < 2; ++s2) S[dkb] = __builtin_amdgcn_mfma_f32_32x32x16_bf16(kdf[dkb * 2 + s2], vf2[s2], S[dkb], 0, 0, 0);
                }
            } else if (wave < 4) {
                const int dvb = wave - 2, sw4 = (r >> 2) & 3;
                const unsigned char* qrow = lds + SC_QE + r * 256;
                const unsigned char* krow_ = lds + SC_KE + r * 256;
                const unsigned char* vrow = lds + SC_VT + (dvb * 32 + r) * 64;
                bf16x8 qf[8], kf[8];
#pragma unroll
                for (int k8 = 0; k8 < 8; ++k8) { const int ch = ((2 * k8 + h) ^ (r & 15)) << 4; kf[k8] = *(const bf16x8*)(krow_ + ch); qf[k8] = *(const bf16x8*)(qrow + ch); }
                uint2 vlo[2], vhi[2];
#pragma unroll
                for (int s2 = 0; s2 < 2; ++s2) { vlo[s2] = *(const uint2*)(vrow + (((2 * s2) ^ sw4) << 4) + 8 * h); vhi[s2] = *(const uint2*)(vrow + (((2 * s2 + 1) ^ sw4) << 4) + 8 * h); }
                f32x16 PT, PT2, Yi;
#pragma unroll
                for (int j = 0; j < 16; ++j) { PT[j] = 0.f; PT2[j] = 0.f; Yi[j] = 0.f; }
#pragma unroll
                for (int k8 = 0; k8 < 8; k8 += 2) {
                    PT = __builtin_amdgcn_mfma_f32_32x32x16_bf16(kf[k8], qf[k8], PT, 0, 0, 0);
                    PT2 = __builtin_amdgcn_mfma_f32_32x32x16_bf16(kf[k8 + 1], qf[k8 + 1], PT2, 0, 0, 0);
                }
                unsigned pp[8];
#pragma unroll
                for (int j = 0; j < 8; ++j) {
                    const int i0 = 2 * j, i1 = 2 * j + 1;
                    const int j0 = (i0 & 3) + 8 * (i0 >> 2) + 4 * h, j1 = (i1 & 3) + 8 * (i1 >> 2) + 4 * h;
                    pp[j] = pk2(j0 <= r ? PT[i0] + PT2[i0] : 0.f, j1 <= r ? PT[i1] + PT2[i1] : 0.f);
                }
#pragma unroll
                for (int s2 = 0; s2 < 2; ++s2) {
                    typedef unsigned u4 __attribute__((ext_vector_type(4)));
                    const u4 t0 = {pp[4 * s2], pp[4 * s2 + 1], pp[4 * s2 + 2], pp[4 * s2 + 3]};
                    const u4 t1 = {vlo[s2].x, vlo[s2].y, vhi[s2].x, vhi[s2].y};
                    Yi = __builtin_amdgcn_mfma_f32_32x32x16_bf16(__builtin_bit_cast(bf16x8, t1), __builtin_bit_cast(bf16x8, t0), Yi, 0, 0, 0);
                }
                float* yo = (float*)(lds + SC_YI) + (dvb * 16) * 64 + lane;
#pragma unroll
                for (int j = 0; j < 16; ++j) yo[j * 64] = Yi[j];
            }
            WAIT_VM0();
            __syncthreads();
        }
        if (wave < 2) {
            const size_t orow = (size_t)bl * TPB + scan_tok((NCH - 1) * 32 + r, dir);
            bf16_t* op = Od + orow * DI_ + hd * 128 + vh * 64 + wave * 32 + 4 * h;
#pragma unroll
            for (int g4 = 0; g4 < 4; ++g4) {
                    const float* yi = (const float*)(lds + SC_YI) + (wave * 16 + 4 * g4) * 64 + lane;
                    uint2 o; o.x = pk2(Ykeep[4 * g4] + yi[0], Ykeep[4 * g4 + 1] + yi[64]); o.y = pk2(Ykeep[4 * g4 + 2] + yi[128], Ykeep[4 * g4 + 3] + yi[192]);
                    *(uint2*)(op + 8 * g4) = o; }
        }
    }
}

__device__ void phase_combine(const Params& p) {
    const bf16_t* OF = (const bf16_t*)(p.ws + OFF_OF);
    const bf16_t* OB = (const bf16_t*)(p.ws + OFF_OB);
    bf16_t* GP = (bf16_t*)(p.ws + OFF_P1 + 4 * PLANE);
    const size_t total = (size_t)GROWS * DI_ / 8;
    const int tid_c = opaque_tid();
    for (size_t it = (size_t)blockIdx.x * NTH + tid_c; it < total; it += (size_t)gridDim.x * NTH) {
        const size_t e0 = it * 8;
        const int c = (int)(e0 & 2047);
        const uint4 a = *(const uint4*)(OF + e0), b = *(const uint4*)(OB + e0), gt = *(const uint4*)(GP + e0);
        const unsigned as[4] = {a.x, a.y, a.z, a.w}, bs[4] = {b.x, b.y, b.z, b.w}, gs[4] = {gt.x, gt.y, gt.z, gt.w};
        float o[8], ss = 0.f;
#pragma unroll
        for (int j = 0; j < 4; ++j) { o[2 * j] = bf_lo(as[j]) + bf_lo(bs[j]); o[2 * j + 1] = bf_hi(as[j]) + bf_hi(bs[j]); ss += o[2 * j] * o[2 * j] + o[2 * j + 1] * o[2 * j + 1]; }
        ss += __shfl_xor(ss, 1); ss += __shfl_xor(ss, 2); ss += __shfl_xor(ss, 4); ss += __shfl_xor(ss, 8);
        const float rstd = rsqrtf(ss * (1.0f / 128.f) + EPS);
        float y[8];
#pragma unroll
        for (int j = 0; j < 4; ++j) {
            y[2 * j] = o[2 * j] * rstd * p.hg_norm_g[c + 2 * j] * bf_lo(gs[j]);
            y[2 * j + 1] = o[2 * j + 1] * rstd * p.hg_norm_g[c + 2 * j + 1] * bf_hi(gs[j]);
        }
        uint4 r; r.x = pk2(y[0], y[1]); r.y = pk2(y[2], y[3]); r.z = pk2(y[4], y[5]); r.w = pk2(y[6], y[7]);
        *(uint4*)((bf16_t*)(p.ws + OFF_OF) + e0) = r;
    }
}

constexpr int AT_STAGE = 32768;
DI float rowmax16(const f32x16& s) {
    float m = fmaxf(fmaxf(s[0], s[1]), fmaxf(s[2], s[3]));
    m = fmaxf(m, fmaxf(fmaxf(s[4], s[5]), fmaxf(s[6], s[7])));
    m = fmaxf(m, fmaxf(fmaxf(s[8], s[9]), fmaxf(s[10], s[11])));
    m = fmaxf(m, fmaxf(fmaxf(s[12], s[13]), fmaxf(s[14], s[15])));
    return m;
}
DI void attn_issue(const bf16_t* gk, const bf16_t* gv, unsigned char* __restrict__ dst, int wave) {
#pragma unroll
    for (int i = 0; i < 2; ++i) {
        __builtin_amdgcn_global_load_lds((const unsigned*)(gk + (size_t)(i * 32) * DI_), (unsigned*)(dst + (i * 8 + wave) * 1024), 16, 0, 0);
        __builtin_amdgcn_global_load_lds((const unsigned*)(gv + (size_t)i * 64 * TPB), (unsigned*)(dst + 16384 + (i * 8 + wave) * 1024), 16, 0, 0);
    }
}
DI void attn_issue_half(const bf16_t* gk, const bf16_t* gv, unsigned char* __restrict__ dst, int wave, int i) {
    __builtin_amdgcn_global_load_lds((const unsigned*)(gk + (size_t)(i * 32) * DI_), (unsigned*)(dst + (i * 8 + wave) * 1024), 16, 0, 0);
    __builtin_amdgcn_global_load_lds((const unsigned*)(gv + (size_t)i * 64 * TPB), (unsigned*)(dst + 16384 + (i * 8 + wave) * 1024), 16, 0, 0);
}
DI void attn_read_k(const unsigned char* kp, int ph, int h, int ksw, bf16x8 (&kf)[4]) {
#pragma unroll
    for (int ks = 0; ks < 4; ++ks) kf[ks] = *(const bf16x8*)(kp + ((8 * ph + 2 * ks + h) ^ ksw) * 16);
}
DI void attn_read_v(const unsigned char* vp, int kb, int h, int vsw, bf16x8 (&vf)[8]) {
#pragma unroll
    for (int s2 = 0; s2 < 2; ++s2)
#pragma unroll
        for (int vb = 0; vb < 4; ++vb) vf[s2 * 4 + vb] = *(const bf16x8*)(vp + vb * 4096 + ((kb * 4 + 2 * s2 + h) ^ vsw) * 16);
}
DI f32x16 attn_qk(const bf16x8 (&kf)[4], const bf16x8 (&Qf)[4], const f32x16& NM) {
    f32x16 S = __builtin_amdgcn_mfma_f32_32x32x16_bf16(kf[0], Qf[0], NM, 0, 0, 0);
#pragma unroll
    for (int ks = 1; ks < 4; ++ks) S = __builtin_amdgcn_mfma_f32_32x32x16_bf16(kf[ks], Qf[ks], S, 0, 0, 0);
    return S;
}
DI void attn_softmax(f32x16& S, float mm_used, bool first, f32x16 (&O)[4], f32x16& NM, float& mm, float& ls, unsigned (&P)[8]) {
    float e[16];
#pragma unroll
    for (int j = 0; j < 16; ++j) e[j] = __builtin_amdgcn_exp2f(S[j]);
    float ps = ((e[0] + e[1]) + (e[2] + e[3])) + ((e[4] + e[5]) + (e[6] + e[7])) + (((e[8] + e[9]) + (e[10] + e[11])) + ((e[12] + e[13]) + (e[14] + e[15])));
    const float adj = mm_used - mm;
    if (first || __any(!(ps <= 4096.f) || adj != 0.f)) {
        float rm = rowmax16(S) + adj;
        rm = fmaxf(rm, __shfl_xor(rm, 32));
        const float dlt = first ? rm : fmaxf(rm, 0.f);
        const float al = first ? 1.0f : __builtin_amdgcn_exp2f(-dlt);
        mm += dlt; ls *= al;
        const float sub = dlt - adj, nm = -mm;
#pragma unroll
        for (int j = 0; j < 16; ++j) { e[j] = __builtin_amdgcn_exp2f(S[j] - sub); NM[j] = nm; }
        ps = ((e[0] + e[1]) + (e[2] + e[3])) + ((e[4] + e[5]) + (e[6] + e[7])) + (((e[8] + e[9]) + (e[10] + e[11])) + ((e[12] + e[13]) + (e[14] + e[15])));
#pragma unroll
        for (int i = 0; i < 4; ++i)
#pragma unroll
            for (int j = 0; j < 16; ++j) O[i][j] *= al;
    }
    ls += ps;
#pragma unroll
    for (int j = 0; j < 8; ++j) P[j] = pk2(e[2 * j], e[2 * j + 1]);
}
DI void attn_pv(const unsigned (&P)[8], const bf16x8 (&vf)[8], f32x16 (&O)[4]) {
#pragma unroll
    for (int s2 = 0; s2 < 2; ++s2) {
        typedef unsigned u4 __attribute__((ext_vector_type(4)));
        const u4 t0 = {P[4 * s2], P[4 * s2 + 1], P[4 * s2 + 2], P[4 * s2 + 3]};
        const bf16x8 pf = __builtin_bit_cast(bf16x8, t0);
#pragma unroll
        for (int vb = 0; vb < 4; ++vb) O[vb] = __builtin_amdgcn_mfma_f32_32x32x16_bf16(vf[s2 * 4 + vb], pf, O[vb], 0, 0, 0);
    }
}
DI void attn_tile(const unsigned char* __restrict__ sCur, const unsigned char* __restrict__ sNxt, unsigned char* __restrict__ dIss, bool has_next, bool last_wait0, bool issue,
                  const bf16_t* gk3, const bf16_t* gv3, int wave, bool first_tile, int pr, int ph, int h, int r, int ksw, int vsw,
                  const bf16x8 (&Qf)[4], f32x16 (&O)[4], f32x16& Snext, f32x16& NM, float& mm_n, float& mm, float& ls) {
    const unsigned char* vp = sCur + 16384 + r * 128;
    bf16x8 kf[4], vf[8];
    unsigned P[8];
    attn_read_k(sCur + (32 + pr) * 256, ph, h, ksw, kf);
    attn_read_v(vp, 0, h, vsw, vf);
    __builtin_amdgcn_sched_barrier(0);
    if (issue) attn_issue_half(gk3, gv3, dIss, wave, 0);
    f32x16 Sc = Snext; float mmc = mm_n;
    Snext = attn_qk(kf, Qf, NM); mm_n = mm;
    attn_softmax(Sc, mmc, first_tile, O, NM, mm, ls, P);
    attn_pv(P, vf, O);
    Sc = Snext; mmc = mm_n;
    attn_read_v(vp, 1, h, vsw, vf);
    if (has_next) {
        if (issue) asm volatile("s_waitcnt vmcnt(6)" ::: "memory"); else if (!last_wait0) asm volatile("s_waitcnt vmcnt(4)" ::: "memory"); else asm volatile("s_waitcnt vmcnt(0)" ::: "memory");
        asm volatile("s_waitcnt lgkmcnt(0)" ::: "memory");
        __builtin_amdgcn_s_barrier();
        attn_read_k(sNxt + pr * 256, ph, h, ksw, kf);
        __builtin_amdgcn_sched_barrier(0);
        if (issue) attn_issue_half(gk3, gv3, dIss, wave, 1);
        Snext = attn_qk(kf, Qf, NM); mm_n = mm;
    }
    attn_softmax(Sc, mmc, false, O, NM, mm, ls, P);
    attn_pv(P, vf, O);
}
__device__ void phase_attn(const Params& p, unsigned char* lds) {
    const int tid = opaque_tid(), lane = tid & 63, wave = __builtin_amdgcn_readfirstlane(tid >> 6), r = lane & 31, h = lane >> 5;
    const int qg = wave >> 1, ph = wave & 1;
    if (wave >= 4) __builtin_amdgcn_s_setprio(1);
    const bf16_t* Qb = (const bf16_t*)(p.ws + OFF_QB);
    const bf16_t* Kb = (const bf16_t*)(p.ws + OFF_KB);
    const bf16_t* Vt = (const bf16_t*)(p.ws + OFF_VT);
    const bf16_t* Gb = (const bf16_t*)(p.ws + OFF_GB);
    bf16_t* Y = (bf16_t*)(p.ws + OFF_Y2);
    const float lam = ((const float*)(p.ws + OFF_SCAL))[0];
    const int xcd = blockIdx.x & 7, lb = blockIdx.x >> 3, nl = gridDim.x >> 3;
    const int pr = (r & ~12) | ((r & 4) << 1) | ((r & 8) >> 1);
    const int kr0 = wave * 4 + (lane >> 4), kchunk = (lane & 15) ^ (kr0 & 15);
    const int vr0 = wave * 8 + (lane >> 3), vchunk = (lane & 7) ^ ((vr0 >> 1) & 7);
    const int vsw = (r >> 1) & 7, ksw = pr & 15;
    float* xch = (float*)(lds + 2 * AT_STAGE);
    constexpr int NT = TPB / 64;
    bf16x8 Qf[4];
#define ATT_COORDS(QQ, BL, HD, L0, GK, GV) const int pair_##BL = xcd * 8 + ((QQ) >> 5), BL = pair_##BL >> 4, HD = pair_##BL & 15, L0 = ((QQ) & 31) * 128 + qg * 32;          \
        const bf16_t* GK = Kb + ((size_t)BL * TPB + kr0) * DI_ + HD * 128 + kchunk * 8; const bf16_t* GV = Vt + ((size_t)(BL * NH + HD) * 128 + vr0) * TPB + vchunk * 8
#define ATT_LOADQ(BL, HD, L0) do { const bf16_t* qp_ = Qb + ((size_t)BL * SEQ + L0 + r) * DI_ + HD * 128 + 64 * ph + 8 * h;                                               \
        _Pragma("unroll") for (int ks = 0; ks < 4; ++ks) Qf[ks] = *(const bf16x8*)(qp_ + 16 * ks); } while (0)
    WAIT_VM0();
    if (lb < 256) { ATT_COORDS(lb, bl0, hd0, l00, gk0, gv0); attn_issue(gk0, gv0, lds, wave); attn_issue(gk0 + (size_t)64 * DI_, gv0 + 64, lds + AT_STAGE, wave); ATT_LOADQ(bl0, hd0, l00); }
    WAIT_VM0();
    __syncthreads();
    for (int q = lb; q < 256; q += nl) {
        ATT_COORDS(q, bl, hd, l0, gk, gv);
        f32x16 O[4];
#pragma unroll
        for (int i = 0; i < 4; ++i)
#pragma unroll
            for (int j = 0; j < 16; ++j) O[i][j] = 0.f;
        float mm = 0.f, ls = 0.f;
        attn_issue(gk + (size_t)128 * DI_, gv + 128, lds + 2 * AT_STAGE, wave);
        bf16x8 kf0[4];
        attn_read_k(lds + pr * 256, ph, h, ksw, kf0);
        f32x16 NM;
#pragma unroll
        for (int j = 0; j < 16; ++j) NM[j] = 0.f;
        f32x16 Snext = attn_qk(kf0, Qf, NM);
        float mm_n = mm;
        for (int kt = 0; kt < NT; ++kt) {
            const int sc = kt & 3, sn = (kt + 1) & 3, si = (kt + 3) & 3;
            attn_tile(lds + sc * AT_STAGE, lds + sn * AT_STAGE, lds + si * AT_STAGE, kt + 1 < NT, kt + 2 >= NT, kt + 3 < NT,
                      gk + (size_t)(kt + 3) * 64 * DI_, gv + (kt + 3) * 64, wave, kt == 0, pr, ph, h, r, ksw, vsw, Qf, O, Snext, NM, mm_n, mm, ls);
        }
        __syncthreads();
        if (q + nl < 256) { ATT_COORDS(q + nl, bln, hdn, l0n, gkn, gvn); ATT_LOADQ(bln, hdn, l0n); attn_issue(gkn, gvn, lds, wave); attn_issue(gkn + (size_t)64 * DI_, gvn + 64, lds + AT_STAGE, wave); }
        ls += __shfl_xor(ls, 32);
        const float inv = (ph ? lam : 1.0f) * __builtin_amdgcn_rcpf(ls);
        if (ph) {
#pragma unroll
            for (int vb = 0; vb < 4; ++vb)
#pragma unroll
                for (int j = 0; j < 16; ++j) xch[(qg * 64 + vb * 16 + j) * 64 + lane] = O[vb][j] * inv;
        }
        __syncthreads();
        if (!ph) {
            float ss = 0.f;
#pragma unroll
            for (int vb = 0; vb < 4; ++vb)
#pragma unroll
                for (int j = 0; j < 16; ++j) { const float o = O[vb][j] * inv - xch[(qg * 64 + vb * 16 + j) * 64 + lane]; O[vb][j] = o; ss += o * o; }
            ss += __shfl_xor(ss, 32);
            const float rstd = rsqrtf(ss * (1.0f / 128.f) + EPS) * (1.0f - LAMBDA_INIT);
            const size_t rowoff = ((size_t)bl * SEQ + l0 + r) * DI_ + hd * 128;
#pragma unroll
            for (int vb = 0; vb < 4; ++vb)
#pragma unroll
                for (int g4 = 0; g4 < 4; ++g4) {
                    const int v = vb * 32 + 8 * g4 + 4 * h;
                    const uint2 gt = *(const uint2*)(Gb + rowoff + v);
                    const f32x4 sg = *(const f32x4*)(p.subln_g + v);
                    const float y0 = O[vb][4 * g4] * rstd * sg[0] * siluf_(bf_lo(gt.x)), y1 = O[vb][4 * g4 + 1] * rstd * sg[1] * siluf_(bf_hi(gt.x));
                    const float y2 = O[vb][4 * g4 + 2] * rstd * sg[2] * siluf_(bf_lo(gt.y)), y3 = O[vb][4 * g4 + 3] * rstd * sg[3] * siluf_(bf_hi(gt.y));
                    uint2 o; o.x = pk2(y0, y1); o.y = pk2(y2, y3);
                    *(uint2*)(Y + rowoff + v) = o;
                }
        }
        WAIT_VM0();
        __syncthreads();
    }
    __builtin_amdgcn_s_setprio(0);
}

__device__ void phase_final(const Params& p) {
    const int tid_ = opaque_tid(), lane = tid_ & 63, wave = tid_ >> 6;
    for (int R = blockIdx.x * NWV + wave; R < NB * SEQ; R += gridDim.x * NWV) {
        float* row = p.out + (size_t)R * D;
        float4 v[4];
        float ss = 0.f;
#pragma unroll
        for (int i = 0; i < 4; ++i) { v[i] = *(const float4*)(row + (i * 64 + lane) * 4); ss += v[i].x * v[i].x + v[i].y * v[i].y + v[i].z * v[i].z + v[i].w * v[i].w; }
        ss = wave_sum(ss);
        const float rstd = rsqrtf(ss * (1.0f / D) + EPS);
#pragma unroll
        for (int i = 0; i < 4; ++i) {
            const int e = (i * 64 + lane) * 4;
            const float4 gg = *(const float4*)(p.final_g + e);
            float4 o; o.x = v[i].x * rstd * gg.x; o.y = v[i].y * rstd * gg.y; o.z = v[i].z * rstd * gg.z; o.w = v[i].w * rstd * gg.w;
            *(float4*)(row + e) = o;
        }
    }
}


#define XB_TMO      128
#define XB_XCNT(j)  (256  + 64 * (j))
#define XB_XSUB(j)  (1280 + 64 * (j))
#define XB_XGEN(j)  (2304 + 64 * (j))
#define XB_TOP      3328
#define XB_TOPGEN   3392
#define XCD_BAR_WORDS 3456
#define XB_SPIN_CAP (1u << 22)
#define LAS __attribute__((address_space(3)))
DI unsigned xb_ld(unsigned* p)              { return __hip_atomic_load(p, __ATOMIC_RELAXED, __HIP_MEMORY_SCOPE_AGENT); }
DI unsigned xb_add(unsigned* p, unsigned v) { return __hip_atomic_fetch_add(p, v, __ATOMIC_RELAXED, __HIP_MEMORY_SCOPE_AGENT); }
DI unsigned xb_xcc_id() { return (unsigned)__builtin_amdgcn_s_getreg((3 << 11) | 20) & 0xFu; }
#define XB_SPIN(cond, bar) do { unsigned _sp = 0; while (cond) { __builtin_amdgcn_s_sleep(1); \
    if ((++_sp & 255u) == 0u) { if (xb_ld(&(bar)[XB_TMO])) break; if (_sp > XB_SPIN_CAP) { atomicAdd(&(bar)[XB_TMO], 1u); break; } } } } while (0)
struct XcdBarrier { unsigned* bar; unsigned x; volatile LAS unsigned* st; };
DI XcdBarrier xcd_barrier_post(unsigned* bar, volatile LAS unsigned* st) {
    XcdBarrier b; b.bar = bar; b.x = xb_xcc_id(); b.st = st;
    if (threadIdx.x == 0) (void)xb_add(&bar[XB_XCNT(b.x)], 1u);
    return b;
}
DI void xcd_barrier_complete(unsigned* bar, unsigned x, unsigned& nloc, unsigned& nx) {
    const unsigned G = gridDim.x * gridDim.y * gridDim.z;
    unsigned sum, cnt, mine, sp = 0u;
    for (;;) {
        sum = 0u; cnt = 0u; mine = 0u;
#pragma unroll
        for (unsigned j = 0; j < 16; ++j) { const unsigned c = xb_ld(&bar[XB_XCNT(j)]); sum += c; cnt += (c > 0u) ? 1u : 0u; mine = (j == x) ? c : mine; }
        if (sum == G) break;
        __builtin_amdgcn_s_sleep(1);
        if ((++sp & 255u) == 0u) { if (xb_ld(&bar[XB_TMO])) break; if (sp > XB_SPIN_CAP) { atomicAdd(&bar[XB_TMO], 1u); break; } }
    }
    nloc = mine > 0u ? mine : 1u; nx = cnt > 0u ? cnt : 1u;
}
DI void xcd_barrier(const XcdBarrier& b) {
    asm volatile("s_waitcnt vmcnt(0)" ::: "memory");
    __syncthreads();
    if (threadIdx.x == 0) {
        unsigned* bar = b.bar;
        __builtin_amdgcn_s_waitcnt(0);
        unsigned nloc = b.st[0], nx = b.st[1];
        if (nloc == 0u) { xcd_barrier_complete(bar, b.x, nloc, nx); b.st[0] = nloc; b.st[1] = nx; }
        const unsigned old = xb_add(&bar[XB_XSUB(b.x)], 1u);
        const unsigned gen = old / nloc;
        if (old + 1u == (gen + 1u) * nloc) {
            __builtin_amdgcn_fence(__ATOMIC_RELEASE, "agent");
            asm volatile("s_waitcnt vmcnt(0)" ::: "memory");
            const unsigned og = xb_add(&bar[XB_TOP], 1u);
            const unsigned tg = og / nx;
            if (og + 1u == (tg + 1u) * nx) xb_add(&bar[XB_TOPGEN], 1u);
            else XB_SPIN(xb_ld(&bar[XB_TOPGEN]) == tg, bar);
            __builtin_amdgcn_fence(__ATOMIC_ACQUIRE, "agent");
            xb_add(&bar[XB_XGEN(b.x)], 1u);
            asm volatile("s_waitcnt vmcnt(0)" ::: "memory");
        } else {
            XB_SPIN(xb_ld(&bar[XB_XGEN(b.x)]) == gen, bar);
            __builtin_amdgcn_fence(__ATOMIC_ACQUIRE, "agent");
            asm volatile("s_waitcnt vmcnt(0)" ::: "memory");
        }
    }
    __syncthreads();
}
constexpr size_t OFF_BAR = 524288;

constexpr int N_PHASES = 18;
constexpr int LDS_BYTES = 3 * G_STAGEB;
#ifndef PH_MASK
#define PH_MASK 0xffffffffu
#endif
#define EN(k) ((PH_MASK >> (k)) & 1u)
#ifndef REP_MASK
#define REP_MASK 0u
#endif
#define REP(k) ((REP_MASK >> (k)) & 1u)
#define PHASE(k, bit, ...) if (p.ph_begin <= (k) && (k) < p.ph_end) { if (EN(bit)) { __VA_ARGS__; } if (REP(bit)) { __VA_ARGS__; } if ((k) + 1 < p.ph_end && (k) != 5 && (k) != 13) { if ((k) == 0) cg::this_grid().sync(); else xcd_barrier(xb); } }
__global__ void __launch_bounds__(512, 2) fwd_megakernel(Params p) {
    __shared__ __attribute__((aligned(1024))) unsigned char lds[LDS_BYTES + 16];
    unsigned char* ws = p.ws;
    volatile LAS unsigned* xst = (volatile LAS unsigned*)(lds + LDS_BYTES);
    if (threadIdx.x == 0) { xst[0] = 0u; xst[1] = 0u; xst[2] = 0u; xst[3] = 0u; }
    __syncthreads();
    XcdBarrier xb = xcd_barrier_post((unsigned*)(ws + OFF_BAR), xst);
    PHASE(0, 0, phase_prologue(p, (float*)lds))
    PHASE(1, 1, phase_modulate(p, 0, p.x, p.ctx, (unsigned char*)p.out, HG_STRIDE))
#pragma unroll 1
    for (int g = 0; g < 2; ++g) {
        PHASE(2 + 4 * g, 2, EpiPlanes e{(bf16_t*)(ws + OFF_P1), (const float*)(ws + OFF_LB)}; gemmh_phase((const bf16_t*)((unsigned char*)p.out + (size_t)g * HG_STRIDE), (const bf16_t*)(ws + OFF_WT_A), GROWS, 10240, 1024, e, lds))
        PHASE(3 + 4 * g, 3, phase_scan(p, lds))
        PHASE(4 + 4 * g, 4, phase_combine(p))
        PHASE(5 + 4 * g, 5, EpiOut0 e{p.x, p.ctx, (const float*)(ws + OFF_MOD), p.out, (float*)(ws + OFF_X1CTX), g}; gemm_phase((const bf16_t*)(ws + OFF_OF), (const bf16_t*)(ws + OFF_WT_B), GROWS, 1024, 2048, e, lds))
    }
    PHASE(10, 6, phase_convert_da(p, (float*)lds); phase_modulate(p, 1, p.out, (const float*)(ws + OFF_X1CTX), ws + OFF_H1, (size_t)GROWS * D * 2))
#pragma unroll 1
    for (int g = 0; g < 2; ++g) {
        PHASE(11 + 3 * g, 7, EpiDA e{(bf16_t*)(ws + OFF_QB), (bf16_t*)(ws + OFF_KB), (bf16_t*)(ws + OFF_VT), (bf16_t*)(ws + OFF_GB)}; gemmh_phase((const bf16_t*)(ws + OFF_H1 + (size_t)g * GROWS * D * 2), (const bf16_t*)(ws + OFF_WT_A), GROWS, 8192, 1024, e, lds))
        PHASE(12 + 3 * g, 8, phase_attn(p, lds))
        PHASE(13 + 3 * g, 9, EpiOut1 e{(const float*)(ws + OFF_MOD) + 9 * 3072, p.out, g}; gemm_phase((const bf16_t*)(ws + OFF_Y2), (const bf16_t*)(ws + OFF_WT_B), GLAT, 1024, 2048, e, lds))
    }
    PHASE(17, 10, phase_final(p))
}

extern "C" void kernel_launch(void* const* d_in, const int* in_sizes, int n_in, void* d_out, int out_size, void* d_ws, size_t ws_size, hipStream_t stream) {
    if (ws_size < WS_NEED) { fprintf(stderr, "workspace too small: %zu < %zu\n", ws_size, (size_t)WS_NEED); return; }
    static int grid_blocks = 0;
    if (!grid_blocks) {
        int dev = 0, cus = 0, per_cu = 0;
        hipGetDevice(&dev);
        hipDeviceGetAttribute(&cus, hipDeviceAttributeMultiprocessorCount, dev);
        hipOccupancyMaxActiveBlocksPerMultiprocessor(&per_cu, fwd_megakernel, NTH, 0);
        if (per_cu > 1) per_cu = 1;
        grid_blocks = cus * per_cu;
        if (grid_blocks < 8) grid_blocks = 8;
        grid_blocks &= ~7;
    }
    hipMemsetAsync((unsigned char*)d_ws + OFF_BAR, 0, XCD_BAR_WORDS * sizeof(unsigned), stream);
    Params p{};
    const float** f = (const float**)&p;
    for (int i = 0; i < 19; ++i) f[i] = (const float*)d_in[i];
    p.out = (float*)d_out; p.ws = (unsigned char*)d_ws;
#if MULTI_LAUNCH
    for (int ph = 0; ph < N_PHASES; ++ph) { p.ph_begin = ph; p.ph_end = ph + 1; hipLaunchKernelGGL(fwd_megakernel, dim3(grid_blocks), dim3(NTH), 0, stream, p); }
#else
    p.ph_begin = 0; p.ph_end = N_PHASES;
    void* args[] = {&p};
    hipError_t e = hipLaunchCooperativeKernel((void*)fwd_megakernel, dim3(grid_blocks), dim3(NTH), args, 0, stream);
    if (e != hipSuccess) fprintf(stderr, "cooperative launch failed: %s (grid %d)\n", hipGetErrorString(e), grid_blocks);
#endif
}
```

```cpp
#include <hip/hip_runtime.h>
#include <hip/hip_cooperative_groups.h>
#include <stdint.h>
#include <stdio.h>
namespace cg = cooperative_groups;

#ifndef MULTI_LAUNCH
#define MULTI_LAUNCH 0
#endif

typedef unsigned short bf16_t;
typedef short bf16x8 __attribute__((ext_vector_type(8)));
typedef float f32x4 __attribute__((ext_vector_type(4)));
typedef float f32x16 __attribute__((ext_vector_type(16)));
typedef __bf16 bf2_t __attribute__((ext_vector_type(2)));
typedef float f2_t __attribute__((ext_vector_type(2)));
#define DI __device__ __forceinline__
constexpr int NTH = 512, NWV = 8;

constexpr int D = 1024, NB = 8, SEQ = 4096, CTX = 256, TPB = SEQ + CTX  ;
constexpr int DI_ = 2048, NH = 16;
constexpr int GB_ = 4;
constexpr int GROWS = GB_ * TPB;
constexpr int GLAT = GB_ * SEQ;
constexpr float EPS = 1e-6f;
constexpr float LAMBDA_INIT = 0.35550906759f;
constexpr float QSCALE = 0.125f * 1.4426950408889634f;

constexpr size_t OFF_MOD = 0;
constexpr size_t OFF_LB = 262144;
constexpr size_t OFF_SCAL = 262144 + 16384;
constexpr size_t OFF_WT_A = 1048576;
constexpr size_t OFF_WT_B = OFF_WT_A + 20971520;
constexpr size_t OFF_X1CTX = OFF_WT_B + 4194304;
constexpr size_t OFF_BIG = OFF_X1CTX + 8388608;
constexpr size_t PLANE = (size_t)GROWS * DI_ * 2;
constexpr size_t OFF_P1 = OFF_BIG;
constexpr size_t OFF_OF = OFF_P1 + 5 * PLANE;
constexpr size_t OFF_OB = OFF_OF + PLANE;
constexpr size_t WS_NEED0 = OFF_OB + PLANE;
constexpr size_t OFF_H1 = OFF_BIG;
constexpr size_t OFF_QB = OFF_H1 + (size_t)NB * TPB * D * 2;
constexpr size_t OFF_KB = OFF_QB + (size_t)GLAT * DI_ * 2;
constexpr size_t OFF_VT = OFF_KB + PLANE;
constexpr size_t OFF_GB = OFF_VT + PLANE;
constexpr size_t OFF_Y2 = OFF_GB + (size_t)GLAT * DI_ * 2;
constexpr size_t WS_NEED1 = OFF_Y2 + (size_t)GLAT * DI_ * 2;
constexpr size_t WS_NEED = WS_NEED0 > WS_NEED1 ? WS_NEED0 : WS_NEED1;
constexpr size_t HG_STRIDE = 67108864;

struct Params {
    const float *x, *c, *ctx, *c_ctx, *w_ada, *b_ada, *norm_g, *hg_w_in, *hg_lb, *hg_norm_g, *hg_w_out;
    const float *da_w_in, *lq1, *lk1, *lq2, *lk2, *subln_g, *da_w_out, *final_g;
    float* out;
    unsigned char* ws;
    int ph_begin, ph_end;
};

DI unsigned pk2(float a, float b) { f2_t v = {a, b}; bf2_t r = __builtin_convertvector(v, bf2_t); return __builtin_bit_cast(unsigned, r); }
DI float bf_lo(unsigned u) { return __uint_as_float(u << 16); }
DI float bf_hi(unsigned u) { return __uint_as_float(u & 0xffff0000u); }
DI float sigmoidf_(float z) { return __builtin_amdgcn_rcpf(1.0f + __builtin_amdgcn_exp2f(-1.4426950408889634f * z)); }
DI float siluf_(float z) { return z * __builtin_amdgcn_rcpf(1.0f + __builtin_amdgcn_exp2f(-1.4426950408889634f * z)); }
DI int opaque_tid() { int t = threadIdx.x; asm volatile("" : "+v"(t)); return t; }
template <int CTRL> DI float qperm(float v) { return __int_as_float(__builtin_amdgcn_mov_dpp(__float_as_int(v), CTRL, 0xF, 0xF, true)); }
DI float wave_sum(float v) {
#pragma unroll
    for (int o = 32; o >= 1; o >>= 1) v += __shfl_xor(v, o);
    return v;
}

DI int perm_row(int n, int mode) {
    if (mode == 0 || n >= 4096) return n;
    const int base = n & ~127, e = n & 127;
    const int p = e >> 6, a = (e >> 5) & 1, s2 = (e >> 4) & 1, i = e & 15;
    return base + 64 * p + 32 * a + 2 * i + s2;
}
__device__ void transpose_tile(const float* __restrict__ W, int K, int N, int tk, int tn, bf16_t* __restrict__ Wt, int mode, float* lds) {
    const int tid = opaque_tid();
    const int k0 = tk * 64, n0 = tn * 64;
#pragma unroll
    for (int i = 0; i < 1024 / NTH; ++i) {
        const int idx = tid + i * NTH, kr = idx >> 4, c4 = idx & 15;
        const float4 v = *(const float4*)(W + (size_t)(k0 + kr) * N + n0 + c4 * 4);
        float* d = lds + kr * 65 + c4 * 4;
        d[0] = v.x; d[1] = v.y; d[2] = v.z; d[3] = v.w;
    }
    __syncthreads();
    {
        const int idx = tid, nr = idx >> 3, kc = idx & 7;
        float f[8];
#pragma unroll
        for (int j = 0; j < 8; ++j) f[j] = lds[(kc * 8 + j) * 65 + nr];
        uint4 o; o.x = pk2(f[0], f[1]); o.y = pk2(f[2], f[3]); o.z = pk2(f[4], f[5]); o.w = pk2(f[6], f[7]);
        *(uint4*)(Wt + (size_t)perm_row(n0 + nr, mode) * K + k0 + kc * 8) = o;
    }
    __syncthreads();
}

__device__ void mod_item(const Params& p, int item, float* lds) {
    const int tid = opaque_tid(), lane = tid & 63, wave = tid >> 6;
    const int layer = item / 48, j = (item % 48) * 64 + lane;
    for (int idx = tid; idx < 9 * 1024; idx += NTH) {
        const int r = idx >> 10, k = idx & 1023;
        const float cv = r < 8 ? p.c[r * 1024 + k] : p.c_ctx[k];
        lds[idx] = siluf_(cv);
    }
    __syncthreads();
    float acc[9];
#pragma unroll
    for (int r = 0; r < 9; ++r) acc[r] = 0.f;
    const float* w = p.w_ada + (size_t)layer * 1024 * 3072 + (size_t)(wave * 128) * 3072 + j;
#pragma unroll 8
    for (int k = 0; k < 128; ++k) {
        const float wv = w[(size_t)k * 3072];
#pragma unroll
        for (int r = 0; r < 9; ++r) acc[r] += lds[r * 1024 + wave * 128 + k] * wv;
    }
    __syncthreads();
    float* part = lds + 9 * 1024;
#pragma unroll
    for (int r = 0; r < 9; ++r) part[(wave * 9 + r) * 64 + lane] = acc[r];
    __syncthreads();
    float* MOD = (float*)(p.ws + OFF_MOD);
    for (int idx = tid; idx < 9 * 64; idx += NTH) {
        const int r = idx >> 6, l = idx & 63, jj = (item % 48) * 64 + l;
        float sum = 0.f;
#pragma unroll
        for (int wv = 0; wv < 8; ++wv) sum += part[(wv * 9 + r) * 64 + l];
        MOD[(layer * 9 + r) * 3072 + jj] = sum + p.b_ada[layer * 3072 + jj];
    }
    __syncthreads();
}

__device__ void misc_item(const Params& p) {
    const int tid = opaque_tid();
    float* LB = (float*)(p.ws + OFF_LB);
    for (int idx = tid; idx < 2 * 2048; idx += NTH) {
        const float l0 = p.hg_lb[idx], l1 = p.hg_lb[2 * 2048 + idx];
        LB[idx] = 1.0f / (1.0f + __expf(l1 - l0));
    }
    if (tid == 0) {
        float s1 = 0.f, s2 = 0.f;
        for (int i = 0; i < 64; ++i) { s1 += p.lq1[i] * p.lk1[i]; s2 += p.lq2[i] * p.lk2[i]; }
        ((float*)(p.ws + OFF_SCAL))[0] = expf(s1) - expf(s2) + LAMBDA_INIT;
    }
}

__device__ void phase_prologue(const Params& p, float* lds) {
    const int n_items = 97 + 2560 + 512;
    for (int it = blockIdx.x; it < n_items; it += gridDim.x) {
        if (it < 96) mod_item(p, it, lds);
        else if (it == 96) misc_item(p);
        else if (it < 97 + 2560) { const int t = it - 97; transpose_tile(p.hg_w_in, 1024, 10240, t / 160, t % 160, (bf16_t*)(p.ws + OFF_WT_A), 0, lds); }
        else { const int t = it - 97 - 2560; transpose_tile(p.hg_w_out, 2048, 1024, t / 16, t % 16, (bf16_t*)(p.ws + OFF_WT_B), 0, lds); }
    }
}
__device__ void phase_convert_da(const Params& p, float* lds) {
    const int n_items = 2048 + 512;
    for (int it = blockIdx.x; it < n_items; it += gridDim.x) {
        if (it < 2048) transpose_tile(p.da_w_in, 1024, 8192, it / 128, it % 128, (bf16_t*)(p.ws + OFF_WT_A), 1, lds);
        else { const int t = it - 2048; transpose_tile(p.da_w_out, 2048, 1024, t / 16, t % 16, (bf16_t*)(p.ws + OFF_WT_B), 0, lds); }
    }
}

__device__ void phase_modulate(const Params& p, int layer, const float* lat, const float* ctxsrc, unsigned char* hbase, size_t hstride) {
    const int tid_ = opaque_tid(), lane = tid_ & 63, wave = tid_ >> 6;
    const float* MOD = (const float*)(p.ws + OFF_MOD);
    const float* g = p.norm_g + layer * 1024;
    for (int R = blockIdx.x * NWV + wave; R < NB * TPB; R += gridDim.x * NWV) {
        const int b = R / TPB, t = R % TPB;
        const float* src = t < CTX ? ctxsrc + ((size_t)b * CTX + t) * D : lat + ((size_t)b * SEQ + (t - CTX)) * D;
        const float* mrow = MOD + (size_t)(layer * 9 + (t < CTX ? 8 : b)) * 3072;
        float4 v[4];
        float ss = 0.f;
#pragma unroll
        for (int i = 0; i < 4; ++i) { v[i] = *(const float4*)(src + (i * 64 + lane) * 4); ss += v[i].x * v[i].x + v[i].y * v[i].y + v[i].z * v[i].z + v[i].w * v[i].w; }
        ss = wave_sum(ss);
        const float rstd = rsqrtf(ss * (1.0f / D) + EPS);
        bf16_t* dst = (bf16_t*)(hbase + (size_t)(b / GB_) * hstride) + ((size_t)(b % GB_) * TPB + t) * D;
#pragma unroll
        for (int i = 0; i < 4; ++i) {
            const int e = (i * 64 + lane) * 4;
            const float4 gg = *(const float4*)(g + e), sh = *(const float4*)(mrow + e), sc = *(const float4*)(mrow + 1024 + e);
            const float h0 = v[i].x * rstd * gg.x * (1.f + sc.x) + sh.x, h1 = v[i].y * rstd * gg.y * (1.f + sc.y) + sh.y;
            const float h2 = v[i].z * rstd * gg.z * (1.f + sc.z) + sh.z, h3 = v[i].w * rstd * gg.w * (1.f + sc.w) + sh.w;
            uint2 o; o.x = pk2(h0, h1); o.y = pk2(h2, h3);
            *(uint2*)(dst + e) = o;
        }
    }
}

#define WAIT_VM0() asm volatile("s_waitcnt vmcnt(0)" ::: "memory")
constexpr int G_ABYTES = 256 * 128, G_BBYTES = 128 * 128, G_STAGEB = G_ABYTES + G_BBYTES;
DI void gemm_issue(const bf16_t* ga, const bf16_t* gb, int K, unsigned char* __restrict__ dst, int wave) {
#pragma unroll
    for (int i = 0; i < 4; ++i) __builtin_amdgcn_global_load_lds((const unsigned*)(ga + (size_t)i * 64 * K), (unsigned*)(dst + (i * 8 + wave) * 1024), 16, 0, 0);
#pragma unroll
    for (int i = 0; i < 2; ++i) __builtin_amdgcn_global_load_lds((const unsigned*)(gb + (size_t)i * 64 * K), (unsigned*)(dst + G_ABYTES + (i * 8 + wave) * 1024), 16, 0, 0);
}
DI void gemm_data(const unsigned char* __restrict__ sA, unsigned char* __restrict__ dNext, bool issue, const bf16_t* ga2, const bf16_t* gb2, int K, int wave,
                  int wm, int wn, int fr, int fq, int rsw, bf16x8 (&af)[2][4], bf16x8 (&bfr)[2][4]) {
    const unsigned char* sB = sA + G_ABYTES;
#pragma unroll
    for (int ks = 0; ks < 2; ++ks)
#pragma unroll
        for (int i = 0; i < 4; ++i) {
            af[ks][i] = *(const bf16x8*)(sA + (wm * 64 + i * 16 + fr) * 128 + ((ks * 4 + fq) ^ rsw) * 16);
            bfr[ks][i] = *(const bf16x8*)(sB + (wn * 64 + i * 16 + fr) * 128 + ((ks * 4 + fq) ^ rsw) * 16);
        }
    __builtin_amdgcn_sched_barrier(0);
    if (issue) gemm_issue(ga2, gb2, K, dNext, wave);
}
DI void gemm_mfma(const bf16x8 (&af)[2][4], const bf16x8 (&bfr)[2][4], bool swapped, f32x4 (&acc)[4][4]) {
#pragma unroll
    for (int ks = 0; ks < 2; ++ks) {
        if (!swapped) {
#pragma unroll
            for (int i = 0; i < 4; ++i)
#pragma unroll
                for (int j = 0; j < 4; ++j) acc[i][j] = __builtin_amdgcn_mfma_f32_16x16x32_bf16(bfr[ks][j], af[ks][i], acc[i][j], 0, 0, 0);
        } else {
#pragma unroll
            for (int i = 0; i < 4; ++i)
#pragma unroll
                for (int j = 0; j < 4; ++j) acc[i][j] = __builtin_amdgcn_mfma_f32_16x16x32_bf16(af[ks][i], bfr[ks][j], acc[i][j], 0, 0, 0);
        }
    }
}
template <int HALF>
DI void gemm_kloop(unsigned char* lds, int& stg, int KT, bool have_next, const bf16_t* ga, const bf16_t* gb, const bf16_t* ga1, const bf16_t* gb1, int K, int wave,
                   int wm, int wn, int fr, int fq, int rsw, bool swapped, f32x4 (&acc)[4][4]) {
    for (int kt = 0; kt < KT; ++kt) {
        bf16x8 af[2][4], bfr[2][4];
        const int s3 = stg >= 1 ? stg - 1 : 2;
        const bool in_tile = kt + 2 < KT, issue = in_tile || have_next;
        const bf16_t* pa = in_tile ? ga + (kt + 2) * 64 : ga1 + (kt + 2 - KT) * 64;
        const bf16_t* pb = in_tile ? gb + (kt + 2) * 64 : gb1 + (kt + 2 - KT) * 64;
        if (HALF == 0) {
            gemm_data(lds + stg * G_STAGEB, lds + s3 * G_STAGEB, issue, pa, pb, K, wave, wm, wn, fr, fq, rsw, af, bfr);
            asm volatile("s_waitcnt lgkmcnt(0)" ::: "memory");
            __builtin_amdgcn_s_barrier();
            gemm_mfma(af, bfr, swapped, acc);
            if (issue) asm volatile("s_waitcnt vmcnt(6)" ::: "memory"); else asm volatile("s_waitcnt vmcnt(0)" ::: "memory");
            __builtin_amdgcn_s_barrier();
        } else {
            __builtin_amdgcn_s_barrier();
            gemm_data(lds + stg * G_STAGEB, lds + s3 * G_STAGEB, issue, pa, pb, K, wave, wm, wn, fr, fq, rsw, af, bfr);
            if (issue) asm volatile("s_waitcnt vmcnt(6)" ::: "memory"); else asm volatile("s_waitcnt vmcnt(0)" ::: "memory");
            asm volatile("s_waitcnt lgkmcnt(0)" ::: "memory");
            __builtin_amdgcn_s_barrier();
            gemm_mfma(af, bfr, swapped, acc);
        }
        stg = stg == 2 ? 0 : stg + 1;
    }
}
struct TileCur { int st, tt; };
template <class Epi>
DI bool gemm_next_tile(TileCur& c, int& m0, int& n0, const Epi& epi, int SNn, int nsuper, int lb, int nl) {
    for (;;) {
        if (c.st >= nsuper) return false;
        const int sm = c.st / SNn, sn = c.st % SNn;
        m0 = (sm * 4 + (c.tt & 3)) * 256; n0 = (sn * 8 + (c.tt >> 2)) * 128;
        c.tt += nl;
        if (c.tt >= 32) { c.tt = lb; c.st += 8; }
        if (!epi.skip(m0, n0)) return true;
    }
}
template <class Epi>
__device__ void gemm_phase(const bf16_t* __restrict__ A, const bf16_t* __restrict__ Bt, int M, int N, int K, const Epi& epi, unsigned char* lds) {
    const int tid = opaque_tid(), lane = tid & 63, wave = __builtin_amdgcn_readfirstlane(tid >> 6), wm = wave >> 1, wn = wave & 1;
    const int fr = lane & 15, fq = lane >> 4;
    const int MT = M / 256, NT = N / 128, SMn = MT / 4, SNn = NT / 8, nsuper = SMn * SNn;
    const int xcd = blockIdx.x & 7, lb = blockIdx.x >> 3, nl = gridDim.x >> 3;
    const int KT = K / 64;
    const int rl = wave * 8 + (lane >> 3), lchunk = (lane & 7) ^ ((rl >> 1) & 7);
    const int rsw = (fr >> 1) & 7;
    TileCur cur{xcd, lb};
    int m0, n0, m1 = 0, n1 = 0;
    bool have = gemm_next_tile(cur, m0, n0, epi, SNn, nsuper, lb, nl);
    WAIT_VM0();
    __syncthreads();
    int stg = 0;
    if (have) {
        const bf16_t* ga = A + (size_t)(m0 + rl) * K + lchunk * 8;
        const bf16_t* gb = Bt + (size_t)(n0 + rl) * K + lchunk * 8;
        gemm_issue(ga, gb, K, lds, wave);
        gemm_issue(ga + 64, gb + 64, K, lds + G_STAGEB, wave);
        asm volatile("s_waitcnt vmcnt(6)" ::: "memory");
    }
    __syncthreads();
    const int half = wave >> 2;
    if (half) __builtin_amdgcn_s_setprio(1);
    while (have) {
        const bool have_next = gemm_next_tile(cur, m1, n1, epi, SNn, nsuper, lb, nl);
        const bool swapped = epi.swapped(n0);
        f32x4 acc[4][4];
#pragma unroll
        for (int i = 0; i < 4; ++i)
#pragma unroll
            for (int j = 0; j < 4; ++j) acc[i][j] = (f32x4){0.f, 0.f, 0.f, 0.f};
        const bf16_t* ga = A + (size_t)(m0 + rl) * K + lchunk * 8;
        const bf16_t* gb = Bt + (size_t)(n0 + rl) * K + lchunk * 8;
        const bf16_t* ga1 = A + (size_t)(m1 + rl) * K + lchunk * 8;
        const bf16_t* gb1 = Bt + (size_t)(n1 + rl) * K + lchunk * 8;
        if (half == 0) gemm_kloop<0>(lds, stg, KT, have_next, ga, gb, ga1, gb1, K, wave, wm, wn, fr, fq, rsw, swapped, acc);
        else gemm_kloop<1>(lds, stg, KT, have_next, ga, gb, ga1, gb1, K, wave, wm, wn, fr, fq, rsw, swapped, acc);
#pragma unroll
        for (int i = 0; i < 4; ++i)
#pragma unroll
            for (int j = 0; j < 4; ++j) epi.store(m0 + wm * 64 + i * 16, n0 + wn * 64 + j * 16, acc[i][j], fr, fq);
        m0 = m1; n0 = n1; have = have_next;
    }
    __builtin_amdgcn_s_setprio(0);
    WAIT_VM0();
    __syncthreads();
}


constexpr int H_ABYTES = 256 * 64, H_STAGEB = 2 * H_ABYTES;
DI void gemmh_issue(const bf16_t* ga, const bf16_t* gb, int K, unsigned char* __restrict__ dst, int wave) {
#pragma unroll
    for (int i = 0; i < 2; ++i) {
        __builtin_amdgcn_global_load_lds((const unsigned*)(ga + (size_t)i * 128 * K), (unsigned*)(dst + (i * 8 + wave) * 1024), 16, 0, 0);
        __builtin_amdgcn_global_load_lds((const unsigned*)(gb + (size_t)i * 128 * K), (unsigned*)(dst + H_ABYTES + (i * 8 + wave) * 1024), 16, 0, 0);
    }
}
DI void gemmh_data(const unsigned char* __restrict__ sA, unsigned char* __restrict__ dNext, bool issue, const bf16_t* ga2, const bf16_t* gb2, int K, int wave,
                   int wm, int wn, int fr, int rpos, bf16x8 (&af)[8], bf16x8 (&bfr)[4]) {
    const unsigned char* sB = sA + H_ABYTES;
#pragma unroll
    for (int i = 0; i < 8; ++i) af[i] = *(const bf16x8*)(sA + (wm * 128 + i * 16 + fr) * 64 + rpos);
#pragma unroll
    for (int j = 0; j < 4; ++j) bfr[j] = *(const bf16x8*)(sB + (wn * 64 + j * 16 + fr) * 64 + rpos);
    __builtin_amdgcn_sched_barrier(0);
    if (issue) gemmh_issue(ga2, gb2, K, dNext, wave);
}
template <bool SW>
DI void gemmh_mfma(const bf16x8 (&af)[8], const bf16x8 (&bfr)[4], f32x4 (&acc)[8][4]) {
    if (!SW) {
#pragma unroll
        for (int i = 0; i < 8; ++i)
#pragma unroll
            for (int j = 0; j < 4; ++j) acc[i][j] = __builtin_amdgcn_mfma_f32_16x16x32_bf16(bfr[j], af[i], acc[i][j], 0, 0, 0);
    } else {
#pragma unroll
        for (int i = 0; i < 8; ++i)
#pragma unroll
            for (int j = 0; j < 4; ++j) acc[i][j] = __builtin_amdgcn_mfma_f32_16x16x32_bf16(af[i], bfr[j], acc[i][j], 0, 0, 0);
    }
}
template <int HALF, bool SW>
DI void gemmh_kloop(unsigned char* lds, int& stg, int KT, bool have_next, const bf16_t* ga, const bf16_t* gb, const bf16_t* ga1, const bf16_t* gb1, int K, int wave,
                    int wm, int wn, int fr, int rpos, f32x4 (&acc)[8][4]) {
    for (int kt = 0; kt < KT; ++kt) {
        bf16x8 af[8], bfr[4];
        const int s3 = stg >= 1 ? stg - 1 : 2;
        const bool in_tile = kt + 2 < KT, issue = in_tile || have_next;
        const bf16_t* pa = in_tile ? ga + (kt + 2) * 32 : ga1 + (kt + 2 - KT) * 32;
        const bf16_t* pb = in_tile ? gb + (kt + 2) * 32 : gb1 + (kt + 2 - KT) * 32;
        if (HALF == 0) {
            gemmh_data(lds + stg * H_STAGEB, lds + s3 * H_STAGEB, issue, pa, pb, K, wave, wm, wn, fr, rpos, af, bfr);
            asm volatile("s_waitcnt lgkmcnt(0)" ::: "memory");
            __builtin_amdgcn_s_barrier();
            gemmh_mfma<SW>(af, bfr, acc);
            if (issue) asm volatile("s_waitcnt vmcnt(4)" ::: "memory"); else asm volatile("s_waitcnt vmcnt(0)" ::: "memory");
            __builtin_amdgcn_s_barrier();
        } else {
            __builtin_amdgcn_s_barrier();
            gemmh_data(lds + stg * H_STAGEB, lds + s3 * H_STAGEB, issue, pa, pb, K, wave, wm, wn, fr, rpos, af, bfr);
            if (issue) asm volatile("s_waitcnt vmcnt(4)" ::: "memory"); else asm volatile("s_waitcnt vmcnt(0)" ::: "memory");
            asm volatile("s_waitcnt lgkmcnt(0)" ::: "memory");
            __builtin_amdgcn_s_barrier();
            gemmh_mfma<SW>(af, bfr, acc);
        }
        stg = stg == 2 ? 0 : stg + 1;
    }
}
template <class Epi>
DI bool gemmh_next_tile(TileCur& c, int& m0, int& n0, const Epi& epi, int SNn, int nsuper, int lb, int nl) {
    for (;;) {
        if (c.st >= nsuper) return false;
        const int sm = c.st / SNn, sn = c.st % SNn;
        m0 = (sm * 4 + (c.tt & 3)) * 256; n0 = (sn * 8 + (c.tt >> 2)) * 256;
        c.tt += nl;
        if (c.tt >= 32) { c.tt = lb; c.st += 8; }
        if (!epi.skip(m0, n0)) return true;
    }
}
template <class Epi>
__device__ void gemmh_phase(const bf16_t* __restrict__ A, const bf16_t* __restrict__ Bt, int M, int N, int K, const Epi& epi, unsigned char* lds) {
    const int tid = opaque_tid(), lane = tid & 63, wave = __builtin_amdgcn_readfirstlane(tid >> 6), wm = wave >> 2, wn = wave & 3;
    const int fr = lane & 15, fq = lane >> 4;
    const int MT = M / 256, NT = N / 256, SMn = MT / 4, SNn = NT / 8, nsuper = SMn * SNn;
    const int xcd = blockIdx.x & 7, lb = blockIdx.x >> 3, nl = gridDim.x >> 3;
    const int KT = K / 32;
    const int rl = wave * 16 + (lane >> 2), lchunk = (lane & 3) ^ ((0 - (lane >> 4)) & 3);
    const int rpos = (fq ^ ((0 - (fr >> 2)) & 3)) << 4;
    TileCur cur{xcd, lb};
    int m0, n0, m1 = 0, n1 = 0;
    bool have = gemmh_next_tile(cur, m0, n0, epi, SNn, nsuper, lb, nl);
    WAIT_VM0();
    __syncthreads();
    int stg = 0;
    if (have) {
        const bf16_t* ga = A + (size_t)(m0 + rl) * K + lchunk * 8;
        const bf16_t* gb = Bt + (size_t)(n0 + rl) * K + lchunk * 8;
        gemmh_issue(ga, gb, K, lds, wave);
        gemmh_issue(ga + 32, gb + 32, K, lds + H_STAGEB, wave);
        asm volatile("s_waitcnt vmcnt(4)" ::: "memory");
    }
    __syncthreads();
    const int half = wave >> 2;
    if (half) __builtin_amdgcn_s_setprio(1);
    while (have) {
        const bool have_next = gemmh_next_tile(cur, m1, n1, epi, SNn, nsuper, lb, nl);
        const bool swapped = epi.swapped(n0);
        f32x4 acc[8][4];
#pragma unroll
        for (int i = 0; i < 8; ++i)
#pragma unroll
            for (int j = 0; j < 4; ++j) acc[i][j] = (f32x4){0.f, 0.f, 0.f, 0.f};
        const bf16_t* ga = A + (size_t)(m0 + rl) * K + lchunk * 8;
        const bf16_t* gb = Bt + (size_t)(n0 + rl) * K + lchunk * 8;
        const bf16_t* ga1 = A + (size_t)(m1 + rl) * K + lchunk * 8;
        const bf16_t* gb1 = Bt + (size_t)(n1 + rl) * K + lchunk * 8;
        if (!swapped) {
            if (half == 0) gemmh_kloop<0, false>(lds, stg, KT, have_next, ga, gb, ga1, gb1, K, wave, wm, wn, fr, rpos, acc);
            else gemmh_kloop<1, false>(lds, stg, KT, have_next, ga, gb, ga1, gb1, K, wave, wm, wn, fr, rpos, acc);
        } else {
            if (half == 0) gemmh_kloop<0, true>(lds, stg, KT, have_next, ga, gb, ga1, gb1, K, wave, wm, wn, fr, rpos, acc);
            else gemmh_kloop<1, true>(lds, stg, KT, have_next, ga, gb, ga1, gb1, K, wave, wm, wn, fr, rpos, acc);
        }
#pragma unroll
        for (int i = 0; i < 8; ++i)
#pragma unroll
            for (int j = 0; j < 4; j += 2) epi.store2(m0 + wm * 128 + i * 16, n0 + wn * 64 + j * 16, acc[i][j], acc[i][j + 1], fr, fq);
        m0 = m1; n0 = n1; have = have_next;
    }
    __builtin_amdgcn_s_setprio(0);
    WAIT_VM0();
    __syncthreads();
}

struct EpiPlanes {
    bf16_t* P; const float* LB;
    DI bool skip(int, int) const { return false; }
    DI bool swapped(int) const { return false; }
    DI uint2 act(int n, const f32x4& a) const {
        const int pl = n >> 11, c = n & 2047;
        float v0 = a[0], v1 = a[1], v2 = a[2], v3 = a[3];
        if (pl == 0 || pl == 4) { v0 = siluf_(v0); v1 = siluf_(v1); v2 = siluf_(v2); v3 = siluf_(v3); }
        else if (pl != 3) {
            const f32x4 lb = *(const f32x4*)(LB + (pl - 1) * 2048 + c);
            v0 = 0.6931471805599453f * __builtin_amdgcn_logf(lb[0] + (1.f - lb[0]) * sigmoidf_(v0)); v1 = 0.6931471805599453f * __builtin_amdgcn_logf(lb[1] + (1.f - lb[1]) * sigmoidf_(v1));
            v2 = 0.6931471805599453f * __builtin_amdgcn_logf(lb[2] + (1.f - lb[2]) * sigmoidf_(v2)); v3 = 0.6931471805599453f * __builtin_amdgcn_logf(lb[3] + (1.f - lb[3]) * sigmoidf_(v3));
        }
        uint2 o; o.x = pk2(v0, v1); o.y = pk2(v2, v3);
        return o;
    }
    DI void store(int mb, int nb, const f32x4& a, int fr, int fq) const {
        const int row = mb + fr, n = nb + fq * 4, pl = n >> 11, c = n & 2047;
        *(uint2*)(P + ((size_t)pl * GROWS + row) * DI_ + c) = act(n, a);
    }
    DI void store2(int mb, int nb, const f32x4& a, const f32x4& b, int fr, int fq) const {
        const uint2 oa = act(nb + fq * 4, a), ob = act(nb + 16 + fq * 4, b);
        const bool odd = fq & 1;
        typedef unsigned u2v __attribute__((ext_vector_type(2)));
        const u2v px = __builtin_amdgcn_permlane16_swap(oa.x, ob.x, false, false), py = __builtin_amdgcn_permlane16_swap(oa.y, ob.y, false, false);
        uint4 o; o.x = px.x; o.y = py.x; o.z = px.y; o.w = py.y;
        const int row = mb + fr, n = nb + (odd ? 16 : 0) + (fq & ~1) * 4, pl = n >> 11, c = n & 2047;
        *(uint4*)(P + ((size_t)pl * GROWS + row) * DI_ + c) = o;
    }
};
struct EpiOut0 {
    const float *x, *ctx, *MOD0; float *out, *x1ctx; int g;
    DI bool skip(int, int) const { return false; }
    DI bool swapped(int) const { return false; }
    DI void store(int mb, int nb, const f32x4& a, int fr, int fq) const {
        const int row = mb + fr, n = nb + fq * 4;
        const int b = g * GB_ + row / TPB, t = row % TPB;
        const bool isctx = t < CTX;
        const f32x4 gt = *(const f32x4*)(MOD0 + (size_t)(isctx ? 8 : b) * 3072 + 2048 + n);
        const size_t idx = isctx ? ((size_t)b * CTX + t) * D + n : ((size_t)b * SEQ + (t - CTX)) * D + n;
        const f32x4 xi = *(const f32x4*)((isctx ? ctx : x) + idx);
        *(f32x4*)((isctx ? x1ctx : out) + idx) = xi + gt * a;
    }
};
struct EpiOut1 {
    const float* MOD1; float* out; int g;
    DI bool skip(int, int) const { return false; }
    DI bool swapped(int) const { return false; }
    DI void store(int mb, int nb, const f32x4& a, int fr, int fq) const {
        const int row = mb + fr, n = nb + fq * 4;
        const int b = g * GB_ + row / SEQ;
        const f32x4 gt = *(const f32x4*)(MOD1 + (size_t)b * 3072 + 2048 + n);
        float* o = out + ((size_t)g * GLAT + row) * D + n;
        *(f32x4*)o = *(const f32x4*)o + gt * a;
    }
};
struct EpiDA {
    bf16_t *Q, *Kb, *Vt, *G;
    DI bool skip(int m0, int n0) const { const int sec = n0 >> 11; return (sec == 0 || sec == 3) && (m0 % TPB) < CTX; }
    DI bool swapped(int n0) const { return (n0 >> 11) == 2; }
    DI uint2 val(int sec, int t, int c, const f32x4& a) const {
        float v0 = a[0], v1 = a[1], v2 = a[2], v3 = a[3];
        if (sec <= 1 && t >= CTX) {
            const int l = t - CTX, ep = c & 127, ax = (ep >> 5) & 1, i0 = (ep & 31) >> 1;
            const float pos = (float)(ax ? (l & 63) : (l >> 6));
            const float a0 = pos * __builtin_amdgcn_exp2f(-0.83048202372184f * (float)i0), a1 = pos * __builtin_amdgcn_exp2f(-0.83048202372184f * (float)(i0 + 1));
            const float c0 = __cosf(a0), s0 = __sinf(a0), c1 = __cosf(a1), s1 = __sinf(a1);
            const float r0 = v0 * c0 - v1 * s0, r1 = v1 * c0 + v0 * s0, r2 = v2 * c1 - v3 * s1, r3 = v3 * c1 + v2 * s1;
            v0 = r0; v1 = r1; v2 = r2; v3 = r3;
        }
        if (sec == 0) { v0 *= QSCALE; v1 *= QSCALE; v2 *= QSCALE; v3 *= QSCALE; }
        uint2 o; o.x = pk2(v0, v1); o.y = pk2(v2, v3);
        return o;
    }
    DI bf16_t* dst(int sec, int row, int bl, int t, int c) const {
        if (sec == 1) return Kb + (size_t)row * DI_ + c;
        return (sec == 0 ? Q : G) + ((size_t)bl * SEQ + (t - CTX)) * DI_ + c;
    }
    DI void store(int mb, int nb, const f32x4& a, int fr, int fq) const {
        const int sec = nb >> 11;
        if (sec == 2) {
            const int row = mb + fq * 4, bl = row / TPB, t = row % TPB, c = (nb & 2047) + fr, hd = c >> 7, e = c & 127;
            uint2 o; o.x = pk2(a[0], a[1]); o.y = pk2(a[2], a[3]);
            *(uint2*)(Vt + ((size_t)(bl * NH + hd) * 128 + e) * TPB + t) = o;
            return;
        }
        const int row = mb + fr, bl = row / TPB, t = row % TPB, c = (nb & 2047) + fq * 4;
        *(uint2*)dst(sec, row, bl, t, c) = val(sec, t, c, a);
    }
    DI void store2(int mb, int nb, const f32x4& a, const f32x4& b, int fr, int fq) const {
        const int sec = nb >> 11;
        const bool odd = fq & 1;
        uint2 oa, ob;
        if (sec == 2) { oa.x = pk2(a[0], a[1]); oa.y = pk2(a[2], a[3]); ob.x = pk2(b[0], b[1]); ob.y = pk2(b[2], b[3]); }
        else {
            const int t = (mb + fr) % TPB, c = (nb & 2047) + fq * 4;
            oa = val(sec, t, c, a); ob = val(sec, t, c + 16, b);
        }
        typedef unsigned u2v __attribute__((ext_vector_type(2)));
        const u2v px = __builtin_amdgcn_permlane16_swap(oa.x, ob.x, false, false), py = __builtin_amdgcn_permlane16_swap(oa.y, ob.y, false, false);
        uint4 o; o.x = px.x; o.y = py.x; o.z = px.y; o.w = py.y;
        if (sec == 2) {
            const int row = mb + (fq & ~1) * 4, bl = row / TPB, t = row % TPB, c = (nb & 2047) + (odd ? 16 : 0) + fr, hd = c >> 7, e = c & 127;
            *(uint4*)(Vt + ((size_t)(bl * NH + hd) * 128 + e) * TPB + t) = o;
            return;
        }
        const int row = mb + fr, bl = row / TPB, t = row % TPB, c = (nb & 2047) + (odd ? 16 : 0) + (fq & ~1) * 4;
        *(uint4*)dst(sec, row, bl, t, c) = o;
    }
};

constexpr int SC_RAWQ = 0, SC_RAWZ = 8320, SC_RAWV = 16640, SC_RAWSTG = 20992;
constexpr int SC_QE = 2 * SC_RAWSTG, SC_KE = SC_QE + 8192, SC_KDT = SC_KE + 8192, SC_VT = SC_KDT + 8192, SC_ER = SC_VT + 4096, SC_EB = SC_ER + 512, SC_YI = SC_EB + 512;
DI int scan_tok(int n, int dir) { return dir == 0 ? n : (n < CTX ? CTX - 1 - n : (TPB + CTX - 1) - n); }
__device__ void phase_scan(const Params& p, unsigned char* lds) {
    const int tid = opaque_tid(), lane = tid & 63, wave = __builtin_amdgcn_readfirstlane(tid >> 6), r = lane & 31, h = lane >> 5;
    const int c = tid >> 2, tq = tid & 3;
    const int pc = (c & ~12) | ((c & 4) << 1) | ((c & 8) >> 1);
    const bf16_t* P1 = (const bf16_t*)(p.ws + OFF_P1);
    for (int u = blockIdx.x; u < 256; u += gridDim.x) {
        const int vh = (u >> 3) & 1, sidx = (u >> 4) * 8 + (u & 7), dir = sidx & 1, hd = (sidx >> 1) & 15, bl = sidx >> 5;
        bf16_t* Od = (bf16_t*)(p.ws + (dir ? OFF_OB : OFF_OF));
        const bf16_t* gq = P1 + hd * 128 + (lane & 15) * 8;
        const bf16_t* gz = P1 + (size_t)(1 + dir) * GROWS * DI_ + hd * 128 + (lane & 15) * 8;
        const bf16_t* gvv = P1 + (size_t)3 * GROWS * DI_ + hd * 128 + vh * 64 + (lane & 7) * 8;
        f32x16 S[4];
#pragma unroll
        for (int i = 0; i < 4; ++i)
#pragma unroll
            for (int j = 0; j < 16; ++j) S[i][j] = 0.f;
        WAIT_VM0();
        {
            const size_t rq = (size_t)bl * TPB + scan_tok(4 * wave + (lane >> 4), dir);
            __builtin_amdgcn_global_load_lds((const unsigned*)(gq + rq * DI_), (unsigned*)(lds + SC_RAWQ + wave * 1040), 16, 0, 0);
            __builtin_amdgcn_global_load_lds((const unsigned*)(gz + rq * DI_), (unsigned*)(lds + SC_RAWZ + wave * 1040), 16, 0, 0);
            if (wave < 4) {
                const size_t rv = (size_t)bl * TPB + scan_tok(8 * wave + (lane >> 3), dir);
                __builtin_amdgcn_global_load_lds((const unsigned*)(gvv + rv * DI_), (unsigned*)(lds + SC_RAWV + wave * 1056), 16, 0, 0);
            }
        }
        WAIT_VM0();
        __syncthreads();
        constexpr int NCH = TPB / 32;
        f32x16 Ykeep;
#pragma unroll
        for (int j = 0; j < 16; ++j) Ykeep[j] = 0.f;
        for (int n = 0; n < NCH; ++n) {
            const unsigned char* raw = lds + (n & 1) * SC_RAWSTG;
            if (n + 1 < NCH) {
                unsigned char* nxt = lds + ((n + 1) & 1) * SC_RAWSTG;
                const size_t rq = (size_t)bl * TPB + scan_tok((n + 1) * 32 + 4 * wave + (lane >> 4), dir);
                __builtin_amdgcn_global_load_lds((const unsigned*)(gq + rq * DI_), (unsigned*)(nxt + SC_RAWQ + wave * 1040), 16, 0, 0);
                __builtin_amdgcn_global_load_lds((const unsigned*)(gz + rq * DI_), (unsigned*)(nxt + SC_RAWZ + wave * 1040), 16, 0, 0);
                if (wave < 4) {
                    const size_t rv = (size_t)bl * TPB + scan_tok((n + 1) * 32 + 8 * wave + (lane >> 3), dir);
                    __builtin_amdgcn_global_load_lds((const unsigned*)(gvv + rv * DI_), (unsigned*)(nxt + SC_RAWV + wave * 1056), 16, 0, 0);
                }
            }
            if (wave < 2 && n > 0) {
                const size_t orow = (size_t)bl * TPB + scan_tok((n - 1) * 32 + r, dir);
                bf16_t* op = Od + orow * DI_ + hd * 128 + vh * 64 + wave * 32 + 4 * h;
#pragma unroll
                for (int g4 = 0; g4 < 4; ++g4) {
                    const float* yi = (const float*)(lds + SC_YI) + (wave * 16 + 4 * g4) * 64 + lane;
                    uint2 o; o.x = pk2(Ykeep[4 * g4] + yi[0], Ykeep[4 * g4 + 1] + yi[64]); o.y = pk2(Ykeep[4 * g4 + 2] + yi[128], Ykeep[4 * g4 + 3] + yi[192]);
                    *(uint2*)(op + 8 * g4) = o; }
            }
            {
                float b[8], kk[8], qs[8];
                float run = 0.f;
#pragma unroll
                for (int i = 0; i < 8; ++i) {
                    const int t = tq * 8 + i, off = (t >> 2) * 1040 + (t & 3) * 256 + c * 2;
                    const float g = __uint_as_float((unsigned)(*(const bf16_t*)(raw + SC_RAWZ + off)) << 16);
                    const float qv = __uint_as_float((unsigned)(*(const bf16_t*)(raw + SC_RAWQ + off)) << 16);
                    run += g; b[i] = run; kk[i] = 1.f - __expf(g); qs[i] = qv;
                }
                float x = run, y = qperm<0x90>(x);
                if (tq >= 1) x += y;
                y = qperm<0x44>(x);
                if (tq >= 2) x += y;
                const float excl = x - run;
                const float Btot = qperm<0xFF>(x);
                const float b7 = b[7] + excl;
                const float rho = qperm<0x55>(b7);
                const float eBr = __expf(Btot - rho);
                unsigned kd[4];
                float kdprev = 0.f;
#pragma unroll
                for (int i = 0; i < 8; ++i) {
                    const int t = tq * 8 + i;
                    const float d = b[i] + excl - rho;
                    const float ea = __expf(d), eb = __builtin_amdgcn_rcpf(ea);
                    const float qe = qs[i] * ea, ke = kk[i] * eb, kdv = ke * eBr;
                    const int addr = t * 256 + (((pc >> 3) ^ (t & 15)) << 4) + (pc & 7) * 2;
                    *(bf16_t*)(lds + SC_QE + addr) = (bf16_t)(pk2(qe, 0.f) & 0xffffu);
                    *(bf16_t*)(lds + SC_KE + addr) = (bf16_t)(pk2(ke, 0.f) & 0xffffu);
                    if (i & 1) kd[i >> 1] = pk2(kdprev, kdv); else kdprev = kdv;
                }
                uint4 kdw; kdw.x = kd[0]; kdw.y = kd[1]; kdw.z = kd[2]; kdw.w = kd[3];
                *(uint4*)(lds + SC_KDT + c * 64 + ((tq ^ ((c >> 2) & 3)) << 4)) = kdw;
                if (tq == 0) { *(float*)(lds + SC_ER + c * 4) = __expf(rho); *(float*)(lds + SC_EB + c * 4) = __expf(Btot); }
                if (tid < 256) {
                    const int dv = c;
                    unsigned short vv[8];
#pragma unroll
                    for (int i = 0; i < 8; ++i) vv[i] = *(const bf16_t*)(raw + SC_RAWV + tq * 1056 + i * 128 + dv * 2);
                    uint4 w; w.x = vv[0] | ((unsigned)vv[1] << 16); w.y = vv[2] | ((unsigned)vv[3] << 16); w.z = vv[4] | ((unsigned)vv[5] << 16); w.w = vv[6] | ((unsigned)vv[7] << 16);
                    *(uint4*)(lds + SC_VT + dv * 64 + ((tq ^ ((dv >> 2) & 3)) << 4)) = w;
                }
            }
            __syncthreads();
            if (wave < 2) {
                const int dvb = wave, sw4 = (r >> 2) & 3;
                const unsigned char* qrow = lds + SC_QE + r * 256;
                const unsigned char* vrow = lds + SC_VT + (dvb * 32 + r) * 64;
                bf16x8 qf[8];
#pragma unroll
                for (int k8 = 0; k8 < 8; ++k8) qf[k8] = *(const bf16x8*)(qrow + (((2 * k8 + h) ^ (r & 15)) << 4));
                f32x16 Y, Y2;
#pragma unroll
                for (int j = 0; j < 16; ++j) { Y[j] = 0.f; Y2[j] = 0.f; }
#pragma unroll
                for (int dkb = 0; dkb < 4; ++dkb) {
                    f32x4 er[4];
#pragma unroll
                    for (int g4 = 0; g4 < 4; ++g4) er[g4] = *(const f32x4*)(lds + SC_ER + (dkb * 32 + 8 * g4 + 4 * h) * 4);
                    unsigned pkd[8];
#pragma unroll
                    for (int g4 = 0; g4 < 4; ++g4) {
                        pkd[2 * g4] = pk2(S[dkb][4 * g4] * er[g4][0], S[dkb][4 * g4 + 1] * er[g4][1]);
                        pkd[2 * g4 + 1] = pk2(S[dkb][4 * g4 + 2] * er[g4][2], S[dkb][4 * g4 + 3] * er[g4][3]);
                    }
                    typedef unsigned u4 __attribute__((ext_vector_type(4)));
                    const u4 t0 = {pkd[0], pkd[1], pkd[2], pkd[3]}, t1 = {pkd[4], pkd[5], pkd[6], pkd[7]};
                    Y = __builtin_amdgcn_mfma_f32_32x32x16_bf16(__builtin_bit_cast(bf16x8, t0), qf[dkb * 2], Y, 0, 0, 0);
                    Y2 = __builtin_amdgcn_mfma_f32_32x32x16_bf16(__builtin_bit_cast(bf16x8, t1), qf[dkb * 2 + 1], Y2, 0, 0, 0);
                }
#pragma unroll
                for (int j = 0; j < 16; ++j) Ykeep[j] = Y[j] + Y2[j];
                bf16x8 kdf[8], vf2[2];
#pragma unroll
                for (int dkb = 0; dkb < 4; ++dkb)
#pragma unroll
                    for (int s2 = 0; s2 < 2; ++s2) kdf[dkb * 2 + s2] = *(const bf16x8*)(lds + SC_KDT + (dkb * 32 + r) * 64 + (((2 * s2 + h) ^ sw4) << 4));
#pragma unroll
                for (int s2 = 0; s2 < 2; ++s2) vf2[s2] = *(const bf16x8*)(vrow + (((2 * s2 + h) ^ sw4) << 4));
#pragma unroll
                for (int dkb = 0; dkb < 4; ++dkb) {
                    f32x4 eb[4];
#pragma unroll
                    for (int g4 = 0; g4 < 4; ++g4) eb[g4] = *(const f32x4*)(lds + SC_EB + (dkb * 32 + 8 * g4 + 4 * h) * 4);
#pragma unroll
                    for (int g4 = 0; g4 < 4; ++g4) { S[dkb][4 * g4] *= eb[g4][0]; S[dkb][4 * g4 + 1] *= eb[g4][1]; S[dkb][4 * g4 + 2] *= eb[g4][2]; S[dkb][4 * g4 + 3] *= eb[g4][3]; }
#pragma unroll
                    for (int s2 = 0; s2 < 2; ++s2) S[dkb] = __builtin_amdgcn_mfma_f32_32x32x16_bf16(kdf[dkb * 2 + s2], vf2[s2], S[dkb], 0, 0, 0);
                }
            } else if (wave < 4) {
                const int dvb = wave - 2, sw4 = (r >> 2) & 3;
                const unsigned char* qrow = lds + SC_QE + r * 256;
                const unsigned char* krow_ = lds + SC_KE + r * 256;
                const unsigned char* vrow = lds + SC_VT + (dvb * 32 + r) * 64;
                bf16x8 qf[8], kf[8];
#pragma unroll
                for (int k8 = 0; k8 < 8; ++k8) { const int ch = ((2 * k8 + h) ^ (r & 15)) << 4; kf[k8] = *(const bf16x8*)(krow_ + ch); qf[k8] = *(const bf16x8*)(qrow + ch); }
                uint2 vlo[2], vhi[2];
#pragma unroll
                for (int s2 = 0; s2 < 2; ++s2) { vlo[s2] = *(const uint2*)(vrow + (((2 * s2) ^ sw4) << 4) + 8 * h); vhi[s2] = *(const uint2*)(vrow + (((2 * s2 + 1) ^ sw4) << 4) + 8 * h); }
                f32x16 PT, PT2, Yi;
#pragma unroll
                for (int j = 0; j < 16; ++j) { PT[j] = 0.f; PT2[j] = 0.f; Yi[j] = 0.f; }
#pragma unroll
                for (int k8 = 0; k8 < 8; k8 += 2) {
                    PT = __builtin_amdgcn_mfma_f32_32x32x16_bf16(kf[k8], qf[k8], PT, 0, 0, 0);
                    PT2 = __builtin_amdgcn_mfma_f32_32x32x16_bf16(kf[k8 + 1], qf[k8 + 1], PT2, 0, 0, 0);
                }
                unsigned pp[8];
#pragma unroll
                for (int j = 0; j < 8; ++j) {
                    const int i0 = 2 * j, i1 = 2 * j + 1;
                    const int j0 = (i0 & 3) + 8 * (i0 >> 2) + 4 * h, j1 = (i1 & 3) + 8 * (i1 >> 2) + 4 * h;
                    pp[j] = pk2(j0 <= r ? PT[i0] + PT2[i0] : 0.f, j1 <= r ? PT[i1] + PT2[i1] : 0.f);
                }
#pragma unroll
                for (int s2 = 0; s2 < 2; ++s2) {
                    typedef unsigned u4 __attribute__((ext_vector_type(4)));
                    const u4 t0 = {pp[4 * s2], pp[4 * s2 + 1], pp[4 * s2 + 2], pp[4 * s2 + 3]};
                    const u4 t1 = {vlo[s2].x, vlo[s2].y, vhi[s2].x, vhi[s2].y};
                    Yi = __builtin_amdgcn_mfma_f32_32x32x16_bf16(__builtin_bit_cast(bf16x8, t1), __builtin_bit_cast(bf16x8, t0), Yi, 0, 0, 0);
                }
                float* yo = (float*)(lds + SC_YI) + (dvb * 16) * 64 + lane;
#pragma unroll
                for (int j = 0; j < 16; ++j) yo[j * 64] = Yi[j];
            }
            WAIT_VM0();
            __syncthreads();
        }
        if (wave < 2) {
            const size_t orow = (size_t)bl * TPB + scan_tok((NCH - 1) * 32 + r, dir);
            bf16_t* op = Od + orow * DI_ + hd * 128 + vh * 64 + wave * 32 + 4 * h;
#pragma unroll
            for (int g4 = 0; g4 < 4; ++g4) {
                    const float* yi = (const float*)(lds + SC_YI) + (wave * 16 + 4 * g4) * 64 + lane;
                    uint2 o; o.x = pk2(Ykeep[4 * g4] + yi[0], Ykeep[4 * g4 + 1] + yi[64]); o.y = pk2(Ykeep[4 * g4 + 2] + yi[128], Ykeep[4 * g4 + 3] + yi[192]);
                    *(uint2*)(op + 8 * g4) = o; }
        }
    }
}

__device__ void phase_combine(const Params& p) {
    const bf16_t* OF = (const bf16_t*)(p.ws + OFF_OF);
    const bf16_t* OB = (const bf16_t*)(p.ws + OFF_OB);
    bf16_t* GP = (bf16_t*)(p.ws + OFF_P1 + 4 * PLANE);
    const size_t total = (size_t)GROWS * DI_ / 8;
    const int tid_c = opaque_tid();
    for (size_t it = (size_t)blockIdx.x * NTH + tid_c; it < total; it += (size_t)gridDim.x * NTH) {
        const size_t e0 = it * 8;
        const int c = (int)(e0 & 2047);
        const uint4 a = *(const uint4*)(OF + e0), b = *(const uint4*)(OB + e0), gt = *(const uint4*)(GP + e0);
        const unsigned as[4] = {a.x, a.y, a.z, a.w}, bs[4] = {b.x, b.y, b.z, b.w}, gs[4] = {gt.x, gt.y, gt.z, gt.w};
        float o[8], ss = 0.f;
#pragma unroll
        for (int j = 0; j < 4; ++j) { o[2 * j] = bf_lo(as[j]) + bf_lo(bs[j]); o[2 * j + 1] = bf_hi(as[j]) + bf_hi(bs[j]); ss += o[2 * j] * o[2 * j] + o[2 * j + 1] * o[2 * j + 1]; }
        ss += __shfl_xor(ss, 1); ss += __shfl_xor(ss, 2); ss += __shfl_xor(ss, 4); ss += __shfl_xor(ss, 8);
        const float rstd = rsqrtf(ss * (1.0f / 128.f) + EPS);
        float y[8];
#pragma unroll
        for (int j = 0; j < 4; ++j) {
            y[2 * j] = o[2 * j] * rstd * p.hg_norm_g[c + 2 * j] * bf_lo(gs[j]);
            y[2 * j + 1] = o[2 * j + 1] * rstd * p.hg_norm_g[c + 2 * j + 1] * bf_hi(gs[j]);
        }
        uint4 r; r.x = pk2(y[0], y[1]); r.y = pk2(y[2], y[3]); r.z = pk2(y[4], y[5]); r.w = pk2(y[6], y[7]);
        *(uint4*)((bf16_t*)(p.ws + OFF_OF) + e0) = r;
    }
}

constexpr int AT_STAGE = 32768;
DI float rowmax16(const f32x16& s) {
    float m = fmaxf(fmaxf(s[0], s[1]), fmaxf(s[2], s[3]));
    m = fmaxf(m, fmaxf(fmaxf(s[4], s[5]), fmaxf(s[6], s[7])));
    m = fmaxf(m, fmaxf(fmaxf(s[8], s[9]), fmaxf(s[10], s[11])));
    m = fmaxf(m, fmaxf(fmaxf(s[12], s[13]), fmaxf(s[14], s[15])));
    return m;
}
DI void attn_issue(const bf16_t* gk, const bf16_t* gv, unsigned char* __restrict__ dst, int wave) {
#pragma unroll
    for (int i = 0; i < 2; ++i) {
        __builtin_amdgcn_global_load_lds((const unsigned*)(gk + (size_t)(i * 32) * DI_), (unsigned*)(dst + (i * 8 + wave) * 1024), 16, 0, 0);
        __builtin_amdgcn_global_load_lds((const unsigned*)(gv + (size_t)i * 64 * TPB), (unsigned*)(dst + 16384 + (i * 8 + wave) * 1024), 16, 0, 0);
    }
}
DI void attn_issue_half(const bf16_t* gk, const bf16_t* gv, unsigned char* __restrict__ dst, int wave, int i) {
    __builtin_amdgcn_global_load_lds((const unsigned*)(gk + (size_t)(i * 32) * DI_), (unsigned*)(dst + (i * 8 + wave) * 1024), 16, 0, 0);
    __builtin_amdgcn_global_load_lds((const unsigned*)(gv + (size_t)i * 64 * TPB), (unsigned*)(dst + 16384 + (i * 8 + wave) * 1024), 16, 0, 0);
}
DI void attn_read_k(const unsigned char* kp, int ph, int h, int ksw, bf16x8 (&kf)[4]) {
#pragma unroll
    for (int ks = 0; ks < 4; ++ks) kf[ks] = *(const bf16x8*)(kp + ((8 * ph + 2 * ks + h) ^ ksw) * 16);
}
DI void attn_read_v(const unsigned char* vp, int kb, int h, int vsw, bf16x8 (&vf)[8]) {
#pragma unroll
    for (int s2 = 0; s2 < 2; ++s2)
#pragma unroll
        for (int vb = 0; vb < 4; ++vb) vf[s2 * 4 + vb] = *(const bf16x8*)(vp + vb * 4096 + ((kb * 4 + 2 * s2 + h) ^ vsw) * 16);
}
DI f32x16 attn_qk(const bf16x8 (&kf)[4], const bf16x8 (&Qf)[4], const f32x16& NM) {
    f32x16 S = __builtin_amdgcn_mfma_f32_32x32x16_bf16(kf[0], Qf[0], NM, 0, 0, 0);
#pragma unroll
    for (int ks = 1; ks < 4; ++ks) S = __builtin_amdgcn_mfma_f32_32x32x16_bf16(kf[ks], Qf[ks], S, 0, 0, 0);
    return S;
}
DI void attn_softmax(f32x16& S, float mm_used, bool first, f32x16 (&O)[4], f32x16& NM, float& mm, float& ls, unsigned (&P)[8]) {
    float e[16];
#pragma unroll
    for (int j = 0; j < 16; ++j) e[j] = __builtin_amdgcn_exp2f(S[j]);
    float ps = ((e[0] + e[1]) + (e[2] + e[3])) + ((e[4] + e[5]) + (e[6] + e[7])) + (((e[8] + e[9]) + (e[10] + e[11])) + ((e[12] + e[13]) + (e[14] + e[15])));
    const float adj = mm_used - mm;
    if (first || __any(!(ps <= 4096.f) || adj != 0.f)) {
        float rm = rowmax16(S) + adj;
        rm = fmaxf(rm, __shfl_xor(rm, 32));
        const float dlt = first ? rm : fmaxf(rm, 0.f);
        const float al = first ? 1.0f : __builtin_amdgcn_exp2f(-dlt);
        mm += dlt; ls *= al;
        const float sub = dlt - adj, nm = -mm;
#pragma unroll
        for (int j = 0; j < 16; ++j) { e[j] = __builtin_amdgcn_exp2f(S[j] - sub); NM[j] = nm; }
        ps = ((e[0] + e[1]) + (e[2] + e[3])) + ((e[4] + e[5]) + (e[6] + e[7])) + (((e[8] + e[9]) + (e[10] + e[11])) + ((e[12] + e[13]) + (e[14] + e[15])));
#pragma unroll
        for (int i = 0; i < 4; ++i)
#pragma unroll
            for (int j = 0; j < 16; ++j) O[i][j] *= al;
    }
    ls += ps;
#pragma unroll
    for (int j = 0; j < 8; ++j) P[j] = pk2(e[2 * j], e[2 * j + 1]);
}
DI void attn_pv(const unsigned (&P)[8], const bf16x8 (&vf)[8], f32x16 (&O)[4]) {
#pragma unroll
    for (int s2 = 0; s2 < 2; ++s2) {
        typedef unsigned u4 __attribute__((ext_vector_type(4)));
        const u4 t0 = {P[4 * s2], P[4 * s2 + 1], P[4 * s2 + 2], P[4 * s2 + 3]};
        const bf16x8 pf = __builtin_bit_cast(bf16x8, t0);
#pragma unroll
        for (int vb = 0; vb < 4; ++vb) O[vb] = __builtin_amdgcn_mfma_f32_32x32x16_bf16(vf[s2 * 4 + vb], pf, O[vb], 0, 0, 0);
    }
}
DI void attn_tile(const unsigned char* __restrict__ sCur, const unsigned char* __restrict__ sNxt, unsigned char* __restrict__ dIss, bool has_next, bool last_wait0, bool issue,
                  const bf16_t* gk3, const bf16_t* gv3, int wave, bool first_tile, int pr, int ph, int h, int r, int ksw, int vsw,
                  const bf16x8 (&Qf)[4], f32x16 (&O)[4], f32x16& Snext, f32x16& NM, float& mm_n, float& mm, float& ls) {
    const unsigned char* vp = sCur + 16384 + r * 128;
    bf16x8 kf[4], vf[8];
    unsigned P[8];
    attn_read_k(sCur + (32 + pr) * 256, ph, h, ksw, kf);
    attn_read_v(vp, 0, h, vsw, vf);
    __builtin_amdgcn_sched_barrier(0);
    if (issue) attn_issue_half(gk3, gv3, dIss, wave, 0);
    f32x16 Sc = Snext; float mmc = mm_n;
    Snext = attn_qk(kf, Qf, NM); mm_n = mm;
    attn_softmax(Sc, mmc, first_tile, O, NM, mm, ls, P);
    attn_pv(P, vf, O);
    Sc = Snext; mmc = mm_n;
    attn_read_v(vp, 1, h, vsw, vf);
    attn_softmax(Sc, mmc, false, O, NM, mm, ls, P);
    if (has_next) {
        if (issue) asm volatile("s_waitcnt vmcnt(6)" ::: "memory"); else if (!last_wait0) asm volatile("s_waitcnt vmcnt(4)" ::: "memory"); else asm volatile("s_waitcnt vmcnt(0)" ::: "memory");
        asm volatile("s_waitcnt lgkmcnt(0)" ::: "memory");
        __builtin_amdgcn_s_barrier();
        attn_read_k(sNxt + pr * 256, ph, h, ksw, kf);
        __builtin_amdgcn_sched_barrier(0);
        if (issue) attn_issue_half(gk3, gv3, dIss, wave, 1);
        Snext = attn_qk(kf, Qf, NM); mm_n = mm;
    }
    attn_pv(P, vf, O);
}
__device__ void phase_attn(const Params& p, unsigned char* lds) {
    const int tid = opaque_tid(), lane = tid & 63, wave = __builtin_amdgcn_readfirstlane(tid >> 6), r = lane & 31, h = lane >> 5;
    const int qg = wave >> 1, ph = wave & 1;
    if (wave >= 4) __builtin_amdgcn_s_setprio(1);
    const bf16_t* Qb = (const bf16_t*)(p.ws + OFF_QB);
    const bf16_t* Kb = (const bf16_t*)(p.ws + OFF_KB);
    const bf16_t* Vt = (const bf16_t*)(p.ws + OFF_VT);
    const bf16_t* Gb = (const bf16_t*)(p.ws + OFF_GB);
    bf16_t* Y = (bf16_t*)(p.ws + OFF_Y2);
    const float lam = ((const float*)(p.ws + OFF_SCAL))[0];
    const int xcd = blockIdx.x & 7, lb = blockIdx.x >> 3, nl = gridDim.x >> 3;
    const int pr = (r & ~12) | ((r & 4) << 1) | ((r & 8) >> 1);
    const int kr0 = wave * 4 + (lane >> 4), kchunk = (lane & 15) ^ (kr0 & 15);
    const int vr0 = wave * 8 + (lane >> 3), vchunk = (lane & 7) ^ ((vr0 >> 1) & 7);
    const int vsw = (r >> 1) & 7, ksw = pr & 15;
    float* xch = (float*)(lds + 2 * AT_STAGE);
    constexpr int NT = TPB / 64;
    bf16x8 Qf[4];
#define ATT_COORDS(QQ, BL, HD, L0, GK, GV) const int pair_##BL = xcd * 8 + ((QQ) >> 5), BL = pair_##BL >> 4, HD = pair_##BL & 15, L0 = ((QQ) & 31) * 128 + qg * 32;          \
        const bf16_t* GK = Kb + ((size_t)BL * TPB + kr0) * DI_ + HD * 128 + kchunk * 8; const bf16_t* GV = Vt + ((size_t)(BL * NH + HD) * 128 + vr0) * TPB + vchunk * 8
#define ATT_LOADQ(BL, HD, L0) do { const bf16_t* qp_ = Qb + ((size_t)BL * SEQ + L0 + r) * DI_ + HD * 128 + 64 * ph + 8 * h;                                               \
        _Pragma("unroll") for (int ks = 0; ks < 4; ++ks) Qf[ks] = *(const bf16x8*)(qp_ + 16 * ks); } while (0)
    WAIT_VM0();
    if (lb < 256) { ATT_COORDS(lb, bl0, hd0, l00, gk0, gv0); attn_issue(gk0, gv0, lds, wave); attn_issue(gk0 + (size_t)64 * DI_, gv0 + 64, lds + AT_STAGE, wave); ATT_LOADQ(bl0, hd0, l00); }
    WAIT_VM0();
    __syncthreads();
    for (int q = lb; q < 256; q += nl) {
        ATT_COORDS(q, bl, hd, l0, gk, gv);
        f32x16 O[4];
#pragma unroll
        for (int i = 0; i < 4; ++i)
#pragma unroll
            for (int j = 0; j < 16; ++j) O[i][j] = 0.f;
        float mm = 0.f, ls = 0.f;
        attn_issue(gk + (size_t)128 * DI_, gv + 128, lds + 2 * AT_STAGE, wave);
        bf16x8 kf0[4];
        attn_read_k(lds + pr * 256, ph, h, ksw, kf0);
        f32x16 NM;
#pragma unroll
        for (int j = 0; j < 16; ++j) NM[j] = 0.f;
        f32x16 Snext = attn_qk(kf0, Qf, NM);
        float mm_n = mm;
        for (int kt = 0; kt < NT; ++kt) {
            const int sc = kt & 3, sn = (kt + 1) & 3, si = (kt + 3) & 3;
            attn_tile(lds + sc * AT_STAGE, lds + sn * AT_STAGE, lds + si * AT_STAGE, kt + 1 < NT, kt + 2 >= NT, kt + 3 < NT,
                      gk + (size_t)(kt + 3) * 64 * DI_, gv + (kt + 3) * 64, wave, kt == 0, pr, ph, h, r, ksw, vsw, Qf, O, Snext, NM, mm_n, mm, ls);
        }
        __syncthreads();
        if (q + nl < 256) { ATT_COORDS(q + nl, bln, hdn, l0n, gkn, gvn); (void)l0n; attn_issue(gkn, gvn, lds, wave); attn_issue(gkn + (size_t)64 * DI_, gvn + 64, lds + AT_STAGE, wave); }
        ls += __shfl_xor(ls, 32);
        const float inv = (ph ? lam : 1.0f) * __builtin_amdgcn_rcpf(ls);
        if (ph) {
#pragma unroll
            for (int vb = 0; vb < 4; ++vb)
#pragma unroll
                for (int j = 0; j < 16; ++j) xch[(qg * 64 + vb * 16 + j) * 64 + lane] = O[vb][j] * inv;
        }
        __syncthreads();
        if (!ph) {
            float ss = 0.f;
#pragma unroll
            for (int vb = 0; vb < 4; ++vb)
#pragma unroll
                for (int j = 0; j < 16; ++j) { const float o = O[vb][j] * inv - xch[(qg * 64 + vb * 16 + j) * 64 + lane]; O[vb][j] = o; ss += o * o; }
            ss += __shfl_xor(ss, 32);
            const float rstd = rsqrtf(ss * (1.0f / 128.f) + EPS) * (1.0f - LAMBDA_INIT);
            const size_t rowoff = ((size_t)bl * SEQ + l0 + r) * DI_ + hd * 128;
#pragma unroll
            for (int vb = 0; vb < 4; ++vb)
#pragma unroll
                for (int g4 = 0; g4 < 4; ++g4) {
                    const int v = vb * 32 + 8 * g4 + 4 * h;
                    const uint2 gt = *(const uint2*)(Gb + rowoff + v);
                    const f32x4 sg = *(const f32x4*)(p.subln_g + v);
                    const float y0 = O[vb][4 * g4] * rstd * sg[0] * siluf_(bf_lo(gt.x)), y1 = O[vb][4 * g4 + 1] * rstd * sg[1] * siluf_(bf_hi(gt.x));
                    const float y2 = O[vb][4 * g4 + 2] * rstd * sg[2] * siluf_(bf_lo(gt.y)), y3 = O[vb][4 * g4 + 3] * rstd * sg[3] * siluf_(bf_hi(gt.y));
                    uint2 o; o.x = pk2(y0, y1); o.y = pk2(y2, y3);
                    *(uint2*)(Y + rowoff + v) = o;
                }
        }
        __builtin_amdgcn_sched_barrier(0);
        if (q + nl < 256) { ATT_COORDS(q + nl, blq, hdq, l0q, gkq, gvq); (void)gkq; (void)gvq; ATT_LOADQ(blq, hdq, l0q); }
        WAIT_VM0();
        __syncthreads();
    }
    __builtin_amdgcn_s_setprio(0);
}

__device__ void phase_final(const Params& p) {
    const int tid_ = opaque_tid(), lane = tid_ & 63, wave = tid_ >> 6;
    for (int R = blockIdx.x * NWV + wave; R < NB * SEQ; R += gridDim.x * NWV) {
        float* row = p.out + (size_t)R * D;
        float4 v[4];
        float ss = 0.f;
#pragma unroll
        for (int i = 0; i < 4; ++i) { v[i] = *(const float4*)(row + (i * 64 + lane) * 4); ss += v[i].x * v[i].x + v[i].y * v[i].y + v[i].z * v[i].z + v[i].w * v[i].w; }
        ss = wave_sum(ss);
        const float rstd = rsqrtf(ss * (1.0f / D) + EPS);
#pragma unroll
        for (int i = 0; i < 4; ++i) {
            const int e = (i * 64 + lane) * 4;
            const float4 gg = *(const float4*)(p.final_g + e);
            float4 o; o.x = v[i].x * rstd * gg.x; o.y = v[i].y * rstd * gg.y; o.z = v[i].z * rstd * gg.z; o.w = v[i].w * rstd * gg.w;
            *(float4*)(row + e) = o;
        }
    }
}


#define XB_TMO      128
#define XB_XCNT(j)  (256  + 64 * (j))
#define XB_XSUB(j)  (1280 + 64 * (j))
#define XB_XGEN(j)  (2304 + 64 * (j))
#define XB_TOP      3328
#define XB_TOPGEN   3392
#define XCD_BAR_WORDS 3456
#define XB_SPIN_CAP (1u << 22)
#define LAS __attribute__((address_space(3)))
DI unsigned xb_ld(unsigned* p)              { return __hip_atomic_load(p, __ATOMIC_RELAXED, __HIP_MEMORY_SCOPE_AGENT); }
DI unsigned xb_add(unsigned* p, unsigned v) { return __hip_atomic_fetch_add(p, v, __ATOMIC_RELAXED, __HIP_MEMORY_SCOPE_AGENT); }
DI unsigned xb_xcc_id() { return (unsigned)__builtin_amdgcn_s_getreg((3 << 11) | 20) & 0xFu; }
#define XB_SPIN(cond, bar) do { unsigned _sp = 0; while (cond) { __builtin_amdgcn_s_sleep(1); \
    if ((++_sp & 255u) == 0u) { if (xb_ld(&(bar)[XB_TMO])) break; if (_sp > XB_SPIN_CAP) { atomicAdd(&(bar)[XB_TMO], 1u); break; } } } } while (0)
struct XcdBarrier { unsigned* bar; unsigned x; volatile LAS unsigned* st; };
DI XcdBarrier xcd_barrier_post(unsigned* bar, volatile LAS unsigned* st) {
    XcdBarrier b; b.bar = bar; b.x = xb_xcc_id(); b.st = st;
    if (threadIdx.x == 0) (void)xb_add(&bar[XB_XCNT(b.x)], 1u);
    return b;
}
DI void xcd_barrier_complete(unsigned* bar, unsigned x, unsigned& nloc, unsigned& nx) {
    const unsigned G = gridDim.x * gridDim.y * gridDim.z;
    unsigned sum, cnt, mine, sp = 0u;
    for (;;) {
        sum = 0u; cnt = 0u; mine = 0u;
#pragma unroll
        for (unsigned j = 0; j < 16; ++j) { const unsigned c = xb_ld(&bar[XB_XCNT(j)]); sum += c; cnt += (c > 0u) ? 1u : 0u; mine = (j == x) ? c : mine; }
        if (sum == G) break;
        __builtin_amdgcn_s_sleep(1);
        if ((++sp & 255u) == 0u) { if (xb_ld(&bar[XB_TMO])) break; if (sp > XB_SPIN_CAP) { atomicAdd(&bar[XB_TMO], 1u); break; } }
    }
    nloc = mine > 0u ? mine : 1u; nx = cnt > 0u ? cnt : 1u;
}
DI void xcd_barrier(const XcdBarrier& b) {
    asm volatile("s_waitcnt vmcnt(0)" ::: "memory");
    __syncthreads();
    if (threadIdx.x == 0) {
        unsigned* bar = b.bar;
        __builtin_amdgcn_s_waitcnt(0);
        unsigned nloc = b.st[0], nx = b.st[1];
        if (nloc == 0u) { xcd_barrier_complete(bar, b.x, nloc, nx); b.st[0] = nloc; b.st[1] = nx; }
        const unsigned old = xb_add(&bar[XB_XSUB(b.x)], 1u);
        const unsigned gen = old / nloc;
        if (old + 1u == (gen + 1u) * nloc) {
            __builtin_amdgcn_fence(__ATOMIC_RELEASE, "agent");
            asm volatile("s_waitcnt vmcnt(0)" ::: "memory");
            const unsigned og = xb_add(&bar[XB_TOP], 1u);
            const unsigned tg = og / nx;
            if (og + 1u == (tg + 1u) * nx) xb_add(&bar[XB_TOPGEN], 1u);
            else XB_SPIN(xb_ld(&bar[XB_TOPGEN]) == tg, bar);
            __builtin_amdgcn_fence(__ATOMIC_ACQUIRE, "agent");
            xb_add(&bar[XB_XGEN(b.x)], 1u);
            asm volatile("s_waitcnt vmcnt(0)" ::: "memory");
        } else {
            XB_SPIN(xb_ld(&bar[XB_XGEN(b.x)]) == gen, bar);
            __builtin_amdgcn_fence(__ATOMIC_ACQUIRE, "agent");
            asm volatile("s_waitcnt vmcnt(0)" ::: "memory");
        }
    }
    __syncthreads();
}
constexpr size_t OFF_BAR = 524288;

constexpr int N_PHASES = 18;
constexpr int LDS_BYTES = 3 * G_STAGEB;
#ifndef PH_MASK
#define PH_MASK 0xffffffffu
#endif
#define EN(k) ((PH_MASK >> (k)) & 1u)
#ifndef REP_MASK
#define REP_MASK 0u
#endif
#define REP(k) ((REP_MASK >> (k)) & 1u)
#define PHASE(k, bit, ...) if (p.ph_begin <= (k) && (k) < p.ph_end) { if (EN(bit)) { __VA_ARGS__; } if (REP(bit)) { __VA_ARGS__; } if ((k) + 1 < p.ph_end && (k) != 5 && (k) != 13) { if ((k) == 0) cg::this_grid().sync(); else xcd_barrier(xb); } }
__global__ void __launch_bounds__(512, 2) fwd_megakernel(Params p) {
    __shared__ __attribute__((aligned(1024))) unsigned char lds[LDS_BYTES + 16];
    unsigned char* ws = p.ws;
    volatile LAS unsigned* xst = (volatile LAS unsigned*)(lds + LDS_BYTES);
    if (threadIdx.x == 0) { xst[0] = 0u; xst[1] = 0u; xst[2] = 0u; xst[3] = 0u; }
    __syncthreads();
    XcdBarrier xb = xcd_barrier_post((unsigned*)(ws + OFF_BAR), xst);
    PHASE(0, 0, phase_prologue(p, (float*)lds))
    PHASE(1, 1, phase_modulate(p, 0, p.x, p.ctx, (unsigned char*)p.out, HG_STRIDE))
#pragma unroll 1
    for (int g = 0; g < 2; ++g) {
        PHASE(2 + 4 * g, 2, EpiPlanes e{(bf16_t*)(ws + OFF_P1), (const float*)(ws + OFF_LB)}; gemmh_phase((const bf16_t*)((unsigned char*)p.out + (size_t)g * HG_STRIDE), (const bf16_t*)(ws + OFF_WT_A), GROWS, 10240, 1024, e, lds))
        PHASE(3 + 4 * g, 3, phase_scan(p, lds))
        PHASE(4 + 4 * g, 4, phase_combine(p))
        PHASE(5 + 4 * g, 5, EpiOut0 e{p.x, p.ctx, (const float*)(ws + OFF_MOD), p.out, (float*)(ws + OFF_X1CTX), g}; gemm_phase((const bf16_t*)(ws + OFF_OF), (const bf16_t*)(ws + OFF_WT_B), GROWS, 1024, 2048, e, lds))
    }
    PHASE(10, 6, phase_convert_da(p, (float*)lds); phase_modulate(p, 1, p.out, (const float*)(ws + OFF_X1CTX), ws + OFF_H1, (size_t)GROWS * D * 2))
#pragma unroll 1
    for (int g = 0; g < 2; ++g) {
        PHASE(11 + 3 * g, 7, EpiDA e{(bf16_t*)(ws + OFF_QB), (bf16_t*)(ws + OFF_KB), (bf16_t*)(ws + OFF_VT), (bf16_t*)(ws + OFF_GB)}; gemmh_phase((const bf16_t*)(ws + OFF_H1 + (size_t)g * GROWS * D * 2), (const bf16_t*)(ws + OFF_WT_A), GROWS, 8192, 1024, e, lds))
        PHASE(12 + 3 * g, 8, phase_attn(p, lds))
        PHASE(13 + 3 * g, 9, EpiOut1 e{(const float*)(ws + OFF_MOD) + 9 * 3072, p.out, g}; gemm_phase((const bf16_t*)(ws + OFF_Y2), (const bf16_t*)(ws + OFF_WT_B), GLAT, 1024, 2048, e, lds))
    }
    PHASE(17, 10, phase_final(p))
}

extern "C" void kernel_launch(void* const* d_in, const int* in_sizes, int n_in, void* d_out, int out_size, void* d_ws, size_t ws_size, hipStream_t stream) {
    if (ws_size < WS_NEED) { fprintf(stderr, "workspace too small: %zu < %zu\n", ws_size, (size_t)WS_NEED); return; }
    static int grid_blocks = 0;
    if (!grid_blocks) {
        int dev = 0, cus = 0, per_cu = 0;
        hipGetDevice(&dev);
        hipDeviceGetAttribute(&cus, hipDeviceAttributeMultiprocessorCount, dev);
        hipOccupancyMaxActiveBlocksPerMultiprocessor(&per_cu, fwd_megakernel, NTH, 0);
        if (per_cu > 1) per_cu = 1;
        grid_blocks = cus * per_cu;
        if (grid_blocks < 8) grid_blocks = 8;
        grid_blocks &= ~7;
    }
    hipMemsetAsync((unsigned char*)d_ws + OFF_BAR, 0, XCD_BAR_WORDS * sizeof(unsigned), stream);
    Params p{};
    const float** f = (const float**)&p;
    for (int i = 0; i < 19; ++i) f[i] = (const float*)d_in[i];
    p.out = (float*)d_out; p.ws = (unsigned char*)d_ws;
#if MULTI_LAUNCH
    for (int ph = 0; ph < N_PHASES; ++ph) { p.ph_begin = ph; p.ph_end = ph + 1; hipLaunchKernelGGL(fwd_megakernel, dim3(grid_blocks), dim3(NTH), 0, stream, p); }
#else
    p.ph_begin = 0; p.ph_end = N_PHASES;
    void* args[] = {&p};
    hipError_t e = hipLaunchCooperativeKernel((void*)fwd_megakernel, dim3(grid_blocks), dim3(NTH), args, 0, stream);
    if (e != hipSuccess) fprintf(stderr, "cooperative launch failed: %s (grid %d)\n", hipGetErrorString(e), grid_blocks);
#endif
}
```

```cpp
#include <hip/hip_runtime.h>
#include <hip/hip_cooperative_groups.h>
#include <stdint.h>
#include <stdio.h>
namespace cg = cooperative_groups;

#ifndef MULTI_LAUNCH
#define MULTI_LAUNCH 0
#endif

typedef unsigned short bf16_t;
typedef short bf16x8 __attribute__((ext_vector_type(8)));
typedef float f32x4 __attribute__((ext_vector_type(4)));
typedef float f32x16 __attribute__((ext_vector_type(16)));
typedef __bf16 bf2_t __attribute__((ext_vector_type(2)));
typedef float f2_t __attribute__((ext_vector_type(2)));
#define DI __device__ __forceinline__
constexpr int NTH = 512, NWV = 8;

constexpr int D = 1024, NB = 8, SEQ = 4096, CTX = 256, TPB = SEQ + CTX  ;
constexpr int DI_ = 2048, NH = 16;
constexpr int GB_ = 4;
constexpr int GROWS = GB_ * TPB;
constexpr int GLAT = GB_ * SEQ;
constexpr float EPS = 1e-6f;
constexpr float LAMBDA_INIT = 0.35550906759f;
constexpr float QSCALE = 0.125f * 1.4426950408889634f;

constexpr size_t OFF_MOD = 0;
constexpr size_t OFF_LB = 262144;
constexpr size_t OFF_SCAL = 262144 + 16384;
constexpr size_t OFF_WT_A = 1048576;
constexpr size_t OFF_WT_B = OFF_WT_A + 20971520;
constexpr size_t OFF_X1CTX = OFF_WT_B + 4194304;
constexpr size_t OFF_BIG = OFF_X1CTX + 8388608;
constexpr size_t PLANE = (size_t)GROWS * DI_ * 2;
constexpr size_t OFF_P1 = OFF_BIG;
constexpr size_t OFF_OF = OFF_P1 + 5 * PLANE;
constexpr size_t OFF_OB = OFF_OF + PLANE;
constexpr size_t WS_NEED0 = OFF_OB + PLANE;
constexpr size_t OFF_H1 = OFF_BIG;
constexpr size_t OFF_QB = OFF_H1 + (size_t)NB * TPB * D * 2;
constexpr size_t OFF_KB = OFF_QB + (size_t)GLAT * DI_ * 2;
constexpr size_t OFF_VT = OFF_KB + PLANE;
constexpr size_t OFF_GB = OFF_VT + PLANE;
constexpr size_t OFF_Y2 = OFF_GB + (size_t)GLAT * DI_ * 2;
constexpr size_t WS_NEED1 = OFF_Y2 + (size_t)GLAT * DI_ * 2;
constexpr size_t WS_NEED = WS_NEED0 > WS_NEED1 ? WS_NEED0 : WS_NEED1;
constexpr size_t HG_STRIDE = 67108864;

struct Params {
    const float *x, *c, *ctx, *c_ctx, *w_ada, *b_ada, *norm_g, *hg_w_in, *hg_lb, *hg_norm_g, *hg_w_out;
    const float *da_w_in, *lq1, *lk1, *lq2, *lk2, *subln_g, *da_w_out, *final_g;
    float* out;
    unsigned char* ws;
    int ph_begin, ph_end;
};

DI unsigned pk2(float a, float b) { f2_t v = {a, b}; bf2_t r = __builtin_convertvector(v, bf2_t); return __builtin_bit_cast(unsigned, r); }
DI float bf_lo(unsigned u) { return __uint_as_float(u << 16); }
DI float bf_hi(unsigned u) { return __uint_as_float(u & 0xffff0000u); }
DI float sigmoidf_(float z) { return __builtin_amdgcn_rcpf(1.0f + __builtin_amdgcn_exp2f(-1.4426950408889634f * z)); }
DI float siluf_(float z) { return z * __builtin_amdgcn_rcpf(1.0f + __builtin_amdgcn_exp2f(-1.4426950408889634f * z)); }
DI int opaque_tid() { int t = threadIdx.x; asm volatile("" : "+v"(t)); return t; }
template <int CTRL> DI float qperm(float v) { return __int_as_float(__builtin_amdgcn_mov_dpp(__float_as_int(v), CTRL, 0xF, 0xF, true)); }
DI float wave_sum(float v) {
#pragma unroll
    for (int o = 32; o >= 1; o >>= 1) v += __shfl_xor(v, o);
    return v;
}

DI int perm_row(int n, int mode) {
    if (mode == 0 || n >= 4096) return n;
    const int base = n & ~127, e = n & 127;
    const int p = e >> 6, a = (e >> 5) & 1, s2 = (e >> 4) & 1, i = e & 15;
    return base + 64 * p + 32 * a + 2 * i + s2;
}
__device__ void transpose_tile(const float* __restrict__ W, int K, int N, int tk, int tn, bf16_t* __restrict__ Wt, int mode, float* lds) {
    const int tid = opaque_tid();
    const int k0 = tk * 64, n0 = tn * 64;
#pragma unroll
    for (int i = 0; i < 1024 / NTH; ++i) {
        const int idx = tid + i * NTH, kr = idx >> 4, c4 = idx & 15;
        const float4 v = *(const float4*)(W + (size_t)(k0 + kr) * N + n0 + c4 * 4);
        float* d = lds + kr * 65 + c4 * 4;
        d[0] = v.x; d[1] = v.y; d[2] = v.z; d[3] = v.w;
    }
    __syncthreads();
    {
        const int idx = tid, nr = idx >> 3, kc = idx & 7;
        float f[8];
#pragma unroll
        for (int j = 0; j < 8; ++j) f[j] = lds[(kc * 8 + j) * 65 + nr];
        uint4 o; o.x = pk2(f[0], f[1]); o.y = pk2(f[2], f[3]); o.z = pk2(f[4], f[5]); o.w = pk2(f[6], f[7]);
        *(uint4*)(Wt + (size_t)perm_row(n0 + nr, mode) * K + k0 + kc * 8) = o;
    }
    __syncthreads();
}

__device__ void mod_item(const Params& p, int item, float* lds) {
    const int tid = opaque_tid(), lane = tid & 63, wave = tid >> 6;
    const int layer = item / 48, j = (item % 48) * 64 + lane;
    for (int idx = tid; idx < 9 * 1024; idx += NTH) {
        const int r = idx >> 10, k = idx & 1023;
        const float cv = r < 8 ? p.c[r * 1024 + k] : p.c_ctx[k];
        lds[idx] = siluf_(cv);
    }
    __syncthreads();
    float acc[9];
#pragma unroll
    for (int r = 0; r < 9; ++r) acc[r] = 0.f;
    const float* w = p.w_ada + (size_t)layer * 1024 * 3072 + (size_t)(wave * 128) * 3072 + j;
#pragma unroll 8
    for (int k = 0; k < 128; ++k) {
        const float wv = w[(size_t)k * 3072];
#pragma unroll
        for (int r = 0; r < 9; ++r) acc[r] += lds[r * 1024 + wave * 128 + k] * wv;
    }
    __syncthreads();
    float* part = lds + 9 * 1024;
#pragma unroll
    for (int r = 0; r < 9; ++r) part[(wave * 9 + r) * 64 + lane] = acc[r];
    __syncthreads();
    float* MOD = (float*)(p.ws + OFF_MOD);
    for (int idx = tid; idx < 9 * 64; idx += NTH) {
        const int r = idx >> 6, l = idx & 63, jj = (item % 48) * 64 + l;
        float sum = 0.f;
#pragma unroll
        for (int wv = 0; wv < 8; ++wv) sum += part[(wv * 9 + r) * 64 + l];
        MOD[(layer * 9 + r) * 3072 + jj] = sum + p.b_ada[layer * 3072 + jj];
    }
    __syncthreads();
}

__device__ void misc_item(const Params& p) {
    const int tid = opaque_tid();
    float* LB = (float*)(p.ws + OFF_LB);
    for (int idx = tid; idx < 2 * 2048; idx += NTH) {
        const float l0 = p.hg_lb[idx], l1 = p.hg_lb[2 * 2048 + idx];
        LB[idx] = 1.0f / (1.0f + __expf(l1 - l0));
    }
    if (tid == 0) {
        float s1 = 0.f, s2 = 0.f;
        for (int i = 0; i < 64; ++i) { s1 += p.lq1[i] * p.lk1[i]; s2 += p.lq2[i] * p.lk2[i]; }
        ((float*)(p.ws + OFF_SCAL))[0] = expf(s1) - expf(s2) + LAMBDA_INIT;
    }
}

__device__ void phase_prologue(const Params& p, float* lds) {
    const int n_items = 97 + 2560 + 512;
    for (int it = blockIdx.x; it < n_items; it += gridDim.x) {
        if (it < 96) mod_item(p, it, lds);
        else if (it == 96) misc_item(p);
        else if (it < 97 + 2560) { const int t = it - 97; transpose_tile(p.hg_w_in, 1024, 10240, t / 160, t % 160, (bf16_t*)(p.ws + OFF_WT_A), 0, lds); }
        else { const int t = it - 97 - 2560; transpose_tile(p.hg_w_out, 2048, 1024, t / 16, t % 16, (bf16_t*)(p.ws + OFF_WT_B), 0, lds); }
    }
}
__device__ void phase_convert_da(const Params& p, float* lds) {
    const int n_items = 2048 + 512;
    for (int it = blockIdx.x; it < n_items; it += gridDim.x) {
        if (it < 2048) transpose_tile(p.da_w_in, 1024, 8192, it / 128, it % 128, (bf16_t*)(p.ws + OFF_WT_A), 1, lds);
        else { const int t = it - 2048; transpose_tile(p.da_w_out, 2048, 1024, t / 16, t % 16, (bf16_t*)(p.ws + OFF_WT_B), 0, lds); }
    }
}

__device__ void phase_modulate(const Params& p, int layer, const float* lat, const float* ctxsrc, unsigned char* hbase, size_t hstride) {
    const int tid_ = opaque_tid(), lane = tid_ & 63, wave = tid_ >> 6;
    const float* MOD = (const float*)(p.ws + OFF_MOD);
    const float* g = p.norm_g + layer * 1024;
    for (int R = blockIdx.x * NWV + wave; R < NB * TPB; R += gridDim.x * NWV) {
        const int b = R / TPB, t = R % TPB;
        const float* src = t < CTX ? ctxsrc + ((size_t)b * CTX + t) * D : lat + ((size_t)b * SEQ + (t - CTX)) * D;
        const float* mrow = MOD + (size_t)(layer * 9 + (t < CTX ? 8 : b)) * 3072;
        float4 v[4];
        float ss = 0.f;
#pragma unroll
        for (int i = 0; i < 4; ++i) { v[i] = *(const float4*)(src + (i * 64 + lane) * 4); ss += v[i].x * v[i].x + v[i].y * v[i].y + v[i].z * v[i].z + v[i].w * v[i].w; }
        ss = wave_sum(ss);
        const float rstd = rsqrtf(ss * (1.0f / D) + EPS);
        bf16_t* dst = (bf16_t*)(hbase + (size_t)(b / GB_) * hstride) + ((size_t)(b % GB_) * TPB + t) * D;
#pragma unroll
        for (int i = 0; i < 4; ++i) {
            const int e = (i * 64 + lane) * 4;
            const float4 gg = *(const float4*)(g + e), sh = *(const float4*)(mrow + e), sc = *(const float4*)(mrow + 1024 + e);
            const float h0 = v[i].x * rstd * gg.x * (1.f + sc.x) + sh.x, h1 = v[i].y * rstd * gg.y * (1.f + sc.y) + sh.y;
            const float h2 = v[i].z * rstd * gg.z * (1.f + sc.z) + sh.z, h3 = v[i].w * rstd * gg.w * (1.f + sc.w) + sh.w;
            uint2 o; o.x = pk2(h0, h1); o.y = pk2(h2, h3);
            *(uint2*)(dst + e) = o;
        }
    }
}

#define WAIT_VM0() asm volatile("s_waitcnt vmcnt(0)" ::: "memory")
constexpr int G_ABYTES = 256 * 128, G_BBYTES = 128 * 128, G_STAGEB = G_ABYTES + G_BBYTES;
DI void gemm_issue(const bf16_t* ga, const bf16_t* gb, int K, unsigned char* __restrict__ dst, int wave) {
#pragma unroll
    for (int i = 0; i < 4; ++i) __builtin_amdgcn_global_load_lds((const unsigned*)(ga + (size_t)i * 64 * K), (unsigned*)(dst + (i * 8 + wave) * 1024), 16, 0, 0);
#pragma unroll
    for (int i = 0; i < 2; ++i) __builtin_amdgcn_global_load_lds((const unsigned*)(gb + (size_t)i * 64 * K), (unsigned*)(dst + G_ABYTES + (i * 8 + wave) * 1024), 16, 0, 0);
}
DI void gemm_data(const unsigned char* __restrict__ sA, unsigned char* __restrict__ dNext, bool issue, const bf16_t* ga2, const bf16_t* gb2, int K, int wave,
                  int wm, int wn, int fr, int fq, int rsw, bf16x8 (&af)[2][4], bf16x8 (&bfr)[2][4]) {
    const unsigned char* sB = sA + G_ABYTES;
#pragma unroll
    for (int ks = 0; ks < 2; ++ks)
#pragma unroll
        for (int i = 0; i < 4; ++i) {
            af[ks][i] = *(const bf16x8*)(sA + (wm * 64 + i * 16 + fr) * 128 + ((ks * 4 + fq) ^ rsw) * 16);
            bfr[ks][i] = *(const bf16x8*)(sB + (wn * 64 + i * 16 + fr) * 128 + ((ks * 4 + fq) ^ rsw) * 16);
        }
    __builtin_amdgcn_sched_barrier(0);
    if (issue) gemm_issue(ga2, gb2, K, dNext, wave);
}
DI void gemm_mfma(const bf16x8 (&af)[2][4], const bf16x8 (&bfr)[2][4], bool swapped, f32x4 (&acc)[4][4]) {
#pragma unroll
    for (int ks = 0; ks < 2; ++ks) {
        if (!swapped) {
#pragma unroll
            for (int i = 0; i < 4; ++i)
#pragma unroll
                for (int j = 0; j < 4; ++j) acc[i][j] = __builtin_amdgcn_mfma_f32_16x16x32_bf16(bfr[ks][j], af[ks][i], acc[i][j], 0, 0, 0);
        } else {
#pragma unroll
            for (int i = 0; i < 4; ++i)
#pragma unroll
                for (int j = 0; j < 4; ++j) acc[i][j] = __builtin_amdgcn_mfma_f32_16x16x32_bf16(af[ks][i], bfr[ks][j], acc[i][j], 0, 0, 0);
        }
    }
}
template <int HALF>
DI void gemm_kloop(unsigned char* lds, int& stg, int KT, bool have_next, const bf16_t* ga, const bf16_t* gb, const bf16_t* ga1, const bf16_t* gb1, int K, int wave,
                   int wm, int wn, int fr, int fq, int rsw, bool swapped, f32x4 (&acc)[4][4]) {
    for (int kt = 0; kt < KT; ++kt) {
        bf16x8 af[2][4], bfr[2][4];
        const int s3 = stg >= 1 ? stg - 1 : 2;
        const bool in_tile = kt + 2 < KT, issue = in_tile || have_next;
        const bf16_t* pa = in_tile ? ga + (kt + 2) * 64 : ga1 + (kt + 2 - KT) * 64;
        const bf16_t* pb = in_tile ? gb + (kt + 2) * 64 : gb1 + (kt + 2 - KT) * 64;
        if (HALF == 0) {
            gemm_data(lds + stg * G_STAGEB, lds + s3 * G_STAGEB, issue, pa, pb, K, wave, wm, wn, fr, fq, rsw, af, bfr);
            asm volatile("s_waitcnt lgkmcnt(0)" ::: "memory");
            __builtin_amdgcn_s_barrier();
            gemm_mfma(af, bfr, swapped, acc);
            if (issue) asm volatile("s_waitcnt vmcnt(6)" ::: "memory"); else asm volatile("s_waitcnt vmcnt(0)" ::: "memory");
            __builtin_amdgcn_s_barrier();
        } else {
            __builtin_amdgcn_s_barrier();
            gemm_data(lds + stg * G_STAGEB, lds + s3 * G_STAGEB, issue, pa, pb, K, wave, wm, wn, fr, fq, rsw, af, bfr);
            if (issue) asm volatile("s_waitcnt vmcnt(6)" ::: "memory"); else asm volatile("s_waitcnt vmcnt(0)" ::: "memory");
            asm volatile("s_waitcnt lgkmcnt(0)" ::: "memory");
            __builtin_amdgcn_s_barrier();
            gemm_mfma(af, bfr, swapped, acc);
        }
        stg = stg == 2 ? 0 : stg + 1;
    }
}
struct TileCur { int st, tt; };
template <class Epi>
DI bool gemm_next_tile(TileCur& c, int& m0, int& n0, const Epi& epi, int SNn, int nsuper, int lb, int nl) {
    for (;;) {
        if (c.st >= nsuper) return false;
        const int sm = c.st / SNn, sn = c.st % SNn;
        m0 = (sm * 4 + (c.tt & 3)) * 256; n0 = (sn * 8 + (c.tt >> 2)) * 128;
        c.tt += nl;
        if (c.tt >= 32) { c.tt = lb; c.st += 8; }
        if (!epi.skip(m0, n0)) return true;
    }
}
template <class Epi>
__device__ void gemm_phase(const bf16_t* __restrict__ A, const bf16_t* __restrict__ Bt, int M, int N, int K, const Epi& epi, unsigned char* lds) {
    const int tid = opaque_tid(), lane = tid & 63, wave = __builtin_amdgcn_readfirstlane(tid >> 6), wm = wave >> 1, wn = wave & 1;
    const int fr = lane & 15, fq = lane >> 4;
    const int MT = M / 256, NT = N / 128, SMn = MT / 4, SNn = NT / 8, nsuper = SMn * SNn;
    const int xcd = blockIdx.x & 7, lb = blockIdx.x >> 3, nl = gridDim.x >> 3;
    const int KT = K / 64;
    const int rl = wave * 8 + (lane >> 3), lchunk = (lane & 7) ^ ((rl >> 1) & 7);
    const int rsw = (fr >> 1) & 7;
    TileCur cur{xcd, lb};
    int m0, n0, m1 = 0, n1 = 0;
    bool have = gemm_next_tile(cur, m0, n0, epi, SNn, nsuper, lb, nl);
    WAIT_VM0();
    __syncthreads();
    int stg = 0;
    if (have) {
        const bf16_t* ga = A + (size_t)(m0 + rl) * K + lchunk * 8;
        const bf16_t* gb = Bt + (size_t)(n0 + rl) * K + lchunk * 8;
        gemm_issue(ga, gb, K, lds, wave);
        gemm_issue(ga + 64, gb + 64, K, lds + G_STAGEB, wave);
        asm volatile("s_waitcnt vmcnt(6)" ::: "memory");
    }
    __syncthreads();
    const int half = wave >> 2;
    if (half) __builtin_amdgcn_s_setprio(1);
    while (have) {
        const bool have_next = gemm_next_tile(cur, m1, n1, epi, SNn, nsuper, lb, nl);
        const bool swapped = epi.swapped(n0);
        f32x4 acc[4][4];
#pragma unroll
        for (int i = 0; i < 4; ++i)
#pragma unroll
            for (int j = 0; j < 4; ++j) acc[i][j] = (f32x4){0.f, 0.f, 0.f, 0.f};
        const bf16_t* ga = A + (size_t)(m0 + rl) * K + lchunk * 8;
        const bf16_t* gb = Bt + (size_t)(n0 + rl) * K + lchunk * 8;
        const bf16_t* ga1 = A + (size_t)(m1 + rl) * K + lchunk * 8;
        const bf16_t* gb1 = Bt + (size_t)(n1 + rl) * K + lchunk * 8;
        if (half == 0) gemm_kloop<0>(lds, stg, KT, have_next, ga, gb, ga1, gb1, K, wave, wm, wn, fr, fq, rsw, swapped, acc);
        else gemm_kloop<1>(lds, stg, KT, have_next, ga, gb, ga1, gb1, K, wave, wm, wn, fr, fq, rsw, swapped, acc);
#pragma unroll
        for (int i = 0; i < 4; ++i)
#pragma unroll
            for (int j = 0; j < 4; ++j) epi.store(m0 + wm * 64 + i * 16, n0 + wn * 64 + j * 16, acc[i][j], fr, fq);
        m0 = m1; n0 = n1; have = have_next;
    }
    __builtin_amdgcn_s_setprio(0);
    WAIT_VM0();
    __syncthreads();
}


constexpr int H_ABYTES = 256 * 64, H_STAGEB = 2 * H_ABYTES;
DI void gemmh_issue(const bf16_t* ga, const bf16_t* gb, int K, unsigned char* __restrict__ dst, int wave) {
#pragma unroll
    for (int i = 0; i < 2; ++i) {
        __builtin_amdgcn_global_load_lds((const unsigned*)(ga + (size_t)i * 128 * K), (unsigned*)(dst + (i * 8 + wave) * 1024), 16, 0, 0);
        __builtin_amdgcn_global_load_lds((const unsigned*)(gb + (size_t)i * 128 * K), (unsigned*)(dst + H_ABYTES + (i * 8 + wave) * 1024), 16, 0, 0);
    }
}
DI void gemmh_data(const unsigned char* __restrict__ sA, unsigned char* __restrict__ dNext, bool issue, const bf16_t* ga2, const bf16_t* gb2, int K, int wave,
                   int wm, int wn, int fr, int rpos, bf16x8 (&af)[8], bf16x8 (&bfr)[4]) {
    const unsigned char* sB = sA + H_ABYTES;
#pragma unroll
    for (int i = 0; i < 8; ++i) af[i] = *(const bf16x8*)(sA + (wm * 128 + i * 16 + fr) * 64 + rpos);
#pragma unroll
    for (int j = 0; j < 4; ++j) bfr[j] = *(const bf16x8*)(sB + (wn * 64 + j * 16 + fr) * 64 + rpos);
    __builtin_amdgcn_sched_barrier(0);
    if (issue) gemmh_issue(ga2, gb2, K, dNext, wave);
}
template <bool SW>
DI void gemmh_mfma(const bf16x8 (&af)[8], const bf16x8 (&bfr)[4], f32x4 (&acc)[8][4]) {
    if (!SW) {
#pragma unroll
        for (int i = 0; i < 8; ++i)
#pragma unroll
            for (int j = 0; j < 4; ++j) acc[i][j] = __builtin_amdgcn_mfma_f32_16x16x32_bf16(bfr[j], af[i], acc[i][j], 0, 0, 0);
    } else {
#pragma unroll
        for (int i = 0; i < 8; ++i)
#pragma unroll
            for (int j = 0; j < 4; ++j) acc[i][j] = __builtin_amdgcn_mfma_f32_16x16x32_bf16(af[i], bfr[j], acc[i][j], 0, 0, 0);
    }
}
template <int HALF, bool SW>
DI void gemmh_kloop(unsigned char* lds, int& stg, int KT, bool have_next, const bf16_t* ga, const bf16_t* gb, const bf16_t* ga1, const bf16_t* gb1, int K, int wave,
                    int wm, int wn, int fr, int rpos, f32x4 (&acc)[8][4]) {
    for (int kt = 0; kt < KT; ++kt) {
        bf16x8 af[8], bfr[4];
        const int s3 = stg >= 1 ? stg - 1 : 2;
        const bool in_tile = kt + 2 < KT, issue = in_tile || have_next;
        const bf16_t* pa = in_tile ? ga + (kt + 2) * 32 : ga1 + (kt + 2 - KT) * 32;
        const bf16_t* pb = in_tile ? gb + (kt + 2) * 32 : gb1 + (kt + 2 - KT) * 32;
        if (HALF == 0) {
            gemmh_data(lds + stg * H_STAGEB, lds + s3 * H_STAGEB, issue, pa, pb, K, wave, wm, wn, fr, rpos, af, bfr);
            asm volatile("s_waitcnt lgkmcnt(0)" ::: "memory");
            __builtin_amdgcn_s_barrier();
            gemmh_mfma<SW>(af, bfr, acc);
            if (issue) asm volatile("s_waitcnt vmcnt(4)" ::: "memory"); else asm volatile("s_waitcnt vmcnt(0)" ::: "memory");
            __builtin_amdgcn_s_barrier();
        } else {
            __builtin_amdgcn_s_barrier();
            gemmh_data(lds + stg * H_STAGEB, lds + s3 * H_STAGEB, issue, pa, pb, K, wave, wm, wn, fr, rpos, af, bfr);
            if (issue) asm volatile("s_waitcnt vmcnt(4)" ::: "memory"); else asm volatile("s_waitcnt vmcnt(0)" ::: "memory");
            asm volatile("s_waitcnt lgkmcnt(0)" ::: "memory");
            __builtin_amdgcn_s_barrier();
            gemmh_mfma<SW>(af, bfr, acc);
        }
        stg = stg == 2 ? 0 : stg + 1;
    }
}
template <class Epi>
DI bool gemmh_next_tile(TileCur& c, int& m0, int& n0, const Epi& epi, int SNn, int nsuper, int lb, int nl) {
    for (;;) {
        if (c.st >= nsuper) return false;
        const int sm = c.st / SNn, sn = c.st % SNn;
        m0 = (sm * 4 + (c.tt & 3)) * 256; n0 = (sn * 8 + (c.tt >> 2)) * 256;
        c.tt += nl;
        if (c.tt >= 32) { c.tt = lb; c.st += 8; }
        if (!epi.skip(m0, n0)) return true;
    }
}
template <class Epi>
__device__ void gemmh_phase(const bf16_t* __restrict__ A, const bf16_t* __restrict__ Bt, int M, int N, int K, const Epi& epi, unsigned char* lds) {
    const int tid = opaque_tid(), lane = tid & 63, wave = __builtin_amdgcn_readfirstlane(tid >> 6), wm = wave >> 2, wn = wave & 3;
    const int fr = lane & 15, fq = lane >> 4;
    const int MT = M / 256, NT = N / 256, SMn = MT / 4, SNn = NT / 8, nsuper = SMn * SNn;
    const int xcd = blockIdx.x & 7, lb = blockIdx.x >> 3, nl = gridDim.x >> 3;
    const int KT = K / 32;
    const int rl = wave * 16 + (lane >> 2), lchunk = (lane & 3) ^ ((0 - (lane >> 4)) & 3);
    const int rpos = (fq ^ ((0 - (fr >> 2)) & 3)) << 4;
    TileCur cur{xcd, lb};
    int m0, n0, m1 = 0, n1 = 0;
    bool have = gemmh_next_tile(cur, m0, n0, epi, SNn, nsuper, lb, nl);
    WAIT_VM0();
    __syncthreads();
    int stg = 0;
    if (have) {
        const bf16_t* ga = A + (size_t)(m0 + rl) * K + lchunk * 8;
        const bf16_t* gb = Bt + (size_t)(n0 + rl) * K + lchunk * 8;
        gemmh_issue(ga, gb, K, lds, wave);
        gemmh_issue(ga + 32, gb + 32, K, lds + H_STAGEB, wave);
        asm volatile("s_waitcnt vmcnt(4)" ::: "memory");
    }
    __syncthreads();
    const int half = wave >> 2;
    if (half) __builtin_amdgcn_s_setprio(1);
    while (have) {
        const bool have_next = gemmh_next_tile(cur, m1, n1, epi, SNn, nsuper, lb, nl);
        const bool swapped = epi.swapped(n0);
        f32x4 acc[8][4];
#pragma unroll
        for (int i = 0; i < 8; ++i)
#pragma unroll
            for (int j = 0; j < 4; ++j) acc[i][j] = (f32x4){0.f, 0.f, 0.f, 0.f};
        const bf16_t* ga = A + (size_t)(m0 + rl) * K + lchunk * 8;
        const bf16_t* gb = Bt + (size_t)(n0 + rl) * K + lchunk * 8;
        const bf16_t* ga1 = A + (size_t)(m1 + rl) * K + lchunk * 8;
        const bf16_t* gb1 = Bt + (size_t)(n1 + rl) * K + lchunk * 8;
        if (!swapped) {
            if (half == 0) gemmh_kloop<0, false>(lds, stg, KT, have_next, ga, gb, ga1, gb1, K, wave, wm, wn, fr, rpos, acc);
            else gemmh_kloop<1, false>(lds, stg, KT, have_next, ga, gb, ga1, gb1, K, wave, wm, wn, fr, rpos, acc);
        } else {
            if (half == 0) gemmh_kloop<0, true>(lds, stg, KT, have_next, ga, gb, ga1, gb1, K, wave, wm, wn, fr, rpos, acc);
            else gemmh_kloop<1, true>(lds, stg, KT, have_next, ga, gb, ga1, gb1, K, wave, wm, wn, fr, rpos, acc);
        }
#pragma unroll
        for (int i = 0; i < 8; ++i)
#pragma unroll
            for (int j = 0; j < 4; j += 2) epi.store2(m0 + wm * 128 + i * 16, n0 + wn * 64 + j * 16, acc[i][j], acc[i][j + 1], fr, fq);
        m0 = m1; n0 = n1; have = have_next;
    }
    __builtin_amdgcn_s_setprio(0);
    WAIT_VM0();
    __syncthreads();
}

struct EpiPlanes {
    bf16_t* P; const float* LB;
    DI bool skip(int, int) const { return false; }
    DI bool swapped(int) const { return false; }
    DI uint2 act(int n, const f32x4& a) const {
        const int pl = n >> 11, c = n & 2047;
        float v0 = a[0], v1 = a[1], v2 = a[2], v3 = a[3];
        if (pl == 0 || pl == 4) { v0 = siluf_(v0); v1 = siluf_(v1); v2 = siluf_(v2); v3 = siluf_(v3); }
        else if (pl != 3) {
            const f32x4 lb = *(const f32x4*)(LB + (pl - 1) * 2048 + c);
            v0 = 0.6931471805599453f * __builtin_amdgcn_logf(lb[0] + (1.f - lb[0]) * sigmoidf_(v0)); v1 = 0.6931471805599453f * __builtin_amdgcn_logf(lb[1] + (1.f - lb[1]) * sigmoidf_(v1));
            v2 = 0.6931471805599453f * __builtin_amdgcn_logf(lb[2] + (1.f - lb[2]) * sigmoidf_(v2)); v3 = 0.6931471805599453f * __builtin_amdgcn_logf(lb[3] + (1.f - lb[3]) * sigmoidf_(v3));
        }
        uint2 o; o.x = pk2(v0, v1); o.y = pk2(v2, v3);
        return o;
    }
    DI void store(int mb, int nb, const f32x4& a, int fr, int fq) const {
        const int row = mb + fr, n = nb + fq * 4, pl = n >> 11, c = n & 2047;
        *(uint2*)(P + ((size_t)pl * GROWS + row) * DI_ + c) = act(n, a);
    }
    DI void store2(int mb, int nb, const f32x4& a, const f32x4& b, int fr, int fq) const {
        const uint2 oa = act(nb + fq * 4, a), ob = act(nb + 16 + fq * 4, b);
        const bool odd = fq & 1;
        typedef unsigned u2v __attribute__((ext_vector_type(2)));
        const u2v px = __builtin_amdgcn_permlane16_swap(oa.x, ob.x, false, false), py = __builtin_amdgcn_permlane16_swap(oa.y, ob.y, false, false);
        uint4 o; o.x = px.x; o.y = py.x; o.z = px.y; o.w = py.y;
        const int row = mb + fr, n = nb + (odd ? 16 : 0) + (fq & ~1) * 4, pl = n >> 11, c = n & 2047;
        *(uint4*)(P + ((size_t)pl * GROWS + row) * DI_ + c) = o;
    }
};
struct EpiOut0 {
    const float *x, *ctx, *MOD0; float *out, *x1ctx; int g;
    DI bool skip(int, int) const { return false; }
    DI bool swapped(int) const { return false; }
    DI void store(int mb, int nb, const f32x4& a, int fr, int fq) const {
        const int row = mb + fr, n = nb + fq * 4;
        const int b = g * GB_ + row / TPB, t = row % TPB;
        const bool isctx = t < CTX;
        const f32x4 gt = *(const f32x4*)(MOD0 + (size_t)(isctx ? 8 : b) * 3072 + 2048 + n);
        const size_t idx = isctx ? ((size_t)b * CTX + t) * D + n : ((size_t)b * SEQ + (t - CTX)) * D + n;
        const f32x4 xi = *(const f32x4*)((isctx ? ctx : x) + idx);
        *(f32x4*)((isctx ? x1ctx : out) + idx) = xi + gt * a;
    }
};
struct EpiOut1 {
    const float* MOD1; float* out; int g;
    DI bool skip(int, int) const { return false; }
    DI bool swapped(int) const { return false; }
    DI void store(int mb, int nb, const f32x4& a, int fr, int fq) const {
        const int row = mb + fr, n = nb + fq * 4;
        const int b = g * GB_ + row / SEQ;
        const f32x4 gt = *(const f32x4*)(MOD1 + (size_t)b * 3072 + 2048 + n);
        float* o = out + ((size_t)g * GLAT + row) * D + n;
        *(f32x4*)o = *(const f32x4*)o + gt * a;
    }
};
struct EpiDA {
    bf16_t *Q, *Kb, *Vt, *G;
    DI bool skip(int m0, int n0) const { const int sec = n0 >> 11; return (sec == 0 || sec == 3) && (m0 % TPB) < CTX; }
    DI bool swapped(int n0) const { return (n0 >> 11) == 2; }
    DI uint2 val(int sec, int t, int c, const f32x4& a) const {
        float v0 = a[0], v1 = a[1], v2 = a[2], v3 = a[3];
        if (sec <= 1 && t >= CTX) {
            const int l = t - CTX, ep = c & 127, ax = (ep >> 5) & 1, i0 = (ep & 31) >> 1;
            const float pos = (float)(ax ? (l & 63) : (l >> 6));
            const float a0 = pos * __builtin_amdgcn_exp2f(-0.83048202372184f * (float)i0), a1 = pos * __builtin_amdgcn_exp2f(-0.83048202372184f * (float)(i0 + 1));
            const float c0 = __cosf(a0), s0 = __sinf(a0), c1 = __cosf(a1), s1 = __sinf(a1);
            const float r0 = v0 * c0 - v1 * s0, r1 = v1 * c0 + v0 * s0, r2 = v2 * c1 - v3 * s1, r3 = v3 * c1 + v2 * s1;
            v0 = r0; v1 = r1; v2 = r2; v3 = r3;
        }
        if (sec == 0) { v0 *= QSCALE; v1 *= QSCALE; v2 *= QSCALE; v3 *= QSCALE; }
        uint2 o; o.x = pk2(v0, v1); o.y = pk2(v2, v3);
        return o;
    }
    DI bf16_t* dst(int sec, int row, int bl, int t, int c) const {
        if (sec == 1) return Kb + (size_t)row * DI_ + c;
        return (sec == 0 ? Q : G) + ((size_t)bl * SEQ + (t - CTX)) * DI_ + c;
    }
    DI void store(int mb, int nb, const f32x4& a, int fr, int fq) const {
        const int sec = nb >> 11;
        if (sec == 2) {
            const int row = mb + fq * 4, bl = row / TPB, t = row % TPB, c = (nb & 2047) + fr, hd = c >> 7, e = c & 127;
            uint2 o; o.x = pk2(a[0], a[1]); o.y = pk2(a[2], a[3]);
            *(uint2*)(Vt + ((size_t)(bl * NH + hd) * 128 + e) * TPB + t) = o;
            return;
        }
        const int row = mb + fr, bl = row / TPB, t = row % TPB, c = (nb & 2047) + fq * 4;
        *(uint2*)dst(sec, row, bl, t, c) = val(sec, t, c, a);
    }
    DI void store2(int mb, int nb, const f32x4& a, const f32x4& b, int fr, int fq) const {
        const int sec = nb >> 11;
        const bool odd = fq & 1;
        uint2 oa, ob;
        if (sec == 2) { oa.x = pk2(a[0], a[1]); oa.y = pk2(a[2], a[3]); ob.x = pk2(b[0], b[1]); ob.y = pk2(b[2], b[3]); }
        else {
            const int t = (mb + fr) % TPB, c = (nb & 2047) + fq * 4;
            oa = val(sec, t, c, a); ob = val(sec, t, c + 16, b);
        }
        typedef unsigned u2v __attribute__((ext_vector_type(2)));
        const u2v px = __builtin_amdgcn_permlane16_swap(oa.x, ob.x, false, false), py = __builtin_amdgcn_permlane16_swap(oa.y, ob.y, false, false);
        uint4 o; o.x = px.x; o.y = py.x; o.z = px.y; o.w = py.y;
        if (sec == 2) {
            const int row = mb + (fq & ~1) * 4, bl = row / TPB, t = row % TPB, c = (nb & 2047) + (odd ? 16 : 0) + fr, hd = c >> 7, e = c & 127;
            *(uint4*)(Vt + ((size_t)(bl * NH + hd) * 128 + e) * TPB + t) = o;
            return;
        }
        const int row = mb + fr, bl = row / TPB, t = row % TPB, c = (nb & 2047) + (odd ? 16 : 0) + (fq & ~1) * 4;
        *(uint4*)dst(sec, row, bl, t, c) = o;
    }
};

constexpr int SC_RAWQ = 0, SC_RAWZ = 8320, SC_RAWV = 16640, SC_RAWSTG = 20992;
constexpr int SC_QE = 2 * SC_RAWSTG, SC_KE = SC_QE + 8192, SC_KDT = SC_KE + 8192, SC_VT = SC_KDT + 8192, SC_ER = SC_VT + 4096, SC_EB = SC_ER + 512, SC_YI = SC_EB + 512;
DI int scan_tok(int n, int dir) { return dir == 0 ? n : (n < CTX ? CTX - 1 - n : (TPB + CTX - 1) - n); }
__device__ void phase_scan(const Params& p, unsigned char* lds) {
    const int tid = opaque_tid(), lane = tid & 63, wave = __builtin_amdgcn_readfirstlane(tid >> 6), r = lane & 31, h = lane >> 5;
    const int c = tid >> 2, tq = tid & 3;
    const int pc = (c & ~12) | ((c & 4) << 1) | ((c & 8) >> 1);
    const bf16_t* P1 = (const bf16_t*)(p.ws + OFF_P1);
    for (int u = blockIdx.x; u < 256; u += gridDim.x) {
        const int vh = (u >> 3) & 1, sidx = (u >> 4) * 8 + (u & 7), dir = sidx & 1, hd = (sidx >> 1) & 15, bl = sidx >> 5;
        bf16_t* Od = (bf16_t*)(p.ws + (dir ? OFF_OB : OFF_OF));
        const bf16_t* gq = P1 + hd * 128 + (lane & 15) * 8;
        const bf16_t* gz = P1 + (size_t)(1 + dir) * GROWS * DI_ + hd * 128 + (lane & 15) * 8;
        const bf16_t* gvv = P1 + (size_t)3 * GROWS * DI_ + hd * 128 + vh * 64 + (lane & 7) * 8;
        f32x16 S[4];
#pragma unroll
        for (int i = 0; i < 4; ++i)
#pragma unroll
            for (int j = 0; j < 16; ++j) S[i][j] = 0.f;
        WAIT_VM0();
        {
            const size_t rq = (size_t)bl * TPB + scan_tok(4 * wave + (lane >> 4), dir);
            __builtin_amdgcn_global_load_lds((const unsigned*)(gq + rq * DI_), (unsigned*)(lds + SC_RAWQ + wave * 1040), 16, 0, 0);
            __builtin_amdgcn_global_load_lds((const unsigned*)(gz + rq * DI_), (unsigned*)(lds + SC_RAWZ + wave * 1040), 16, 0, 0);
            if (wave < 4) {
                const size_t rv = (size_t)bl * TPB + scan_tok(8 * wave + (lane >> 3), dir);
                __builtin_amdgcn_global_load_lds((const unsigned*)(gvv + rv * DI_), (unsigned*)(lds + SC_RAWV + wave * 1056), 16, 0, 0);
            }
        }
        WAIT_VM0();
        __syncthreads();
        constexpr int NCH = TPB / 32;
        f32x16 Ykeep;
#pragma unroll
        for (int j = 0; j < 16; ++j) Ykeep[j] = 0.f;
        for (int n = 0; n < NCH; ++n) {
            const unsigned char* raw = lds + (n & 1) * SC_RAWSTG;
            if (n + 1 < NCH) {
                unsigned char* nxt = lds + ((n + 1) & 1) * SC_RAWSTG;
                const size_t rq = (size_t)bl * TPB + scan_tok((n + 1) * 32 + 4 * wave + (lane >> 4), dir);
                __builtin_amdgcn_global_load_lds((const unsigned*)(gq + rq * DI_), (unsigned*)(nxt + SC_RAWQ + wave * 1040), 16, 0, 0);
                __builtin_amdgcn_global_load_lds((const unsigned*)(gz + rq * DI_), (unsigned*)(nxt + SC_RAWZ + wave * 1040), 16, 0, 0);
                if (wave < 4) {
                    const size_t rv = (size_t)bl * TPB + scan_tok((n + 1) * 32 + 8 * wave + (lane >> 3), dir);
                    __builtin_amdgcn_global_load_lds((const unsigned*)(gvv + rv * DI_), (unsigned*)(nxt + SC_RAWV + wave * 1056), 16, 0, 0);
                }
            }
            if (wave < 2 && n > 0) {
                const size_t orow = (size_t)bl * TPB + scan_tok((n - 1) * 32 + r, dir);
                bf16_t* op = Od + orow * DI_ + hd * 128 + vh * 64 + wave * 32 + 4 * h;
#pragma unroll
                for (int g4 = 0; g4 < 4; ++g4) {
                    const float* yi = (const float*)(lds + SC_YI) + (wave * 16 + 4 * g4) * 64 + lane;
                    uint2 o; o.x = pk2(Ykeep[4 * g4] + yi[0], Ykeep[4 * g4 + 1] + yi[64]); o.y = pk2(Ykeep[4 * g4 + 2] + yi[128], Ykeep[4 * g4 + 3] + yi[192]);
                    *(uint2*)(op + 8 * g4) = o; }
            }
            {
                float b[8], kk[8], qs[8];
                float run = 0.f;
#pragma unroll
                for (int i = 0; i < 8; ++i) {
                    const int t = tq * 8 + i, off = (t >> 2) * 1040 + (t & 3) * 256 + c * 2;
                    const float g = __uint_as_float((unsigned)(*(const bf16_t*)(raw + SC_RAWZ + off)) << 16);
                    const float qv = __uint_as_float((unsigned)(*(const bf16_t*)(raw + SC_RAWQ + off)) << 16);
                    run += g; b[i] = run; kk[i] = 1.f - __expf(g); qs[i] = qv;
                }
                float x = run, y = qperm<0x90>(x);
                if (tq >= 1) x += y;
                y = qperm<0x44>(x);
                if (tq >= 2) x += y;
                const float excl = x - run;
                const float Btot = qperm<0xFF>(x);
                const float b7 = b[7] + excl;
                const float rho = qperm<0x55>(b7);
                const float eBr = __expf(Btot - rho);
                unsigned kd[4];
                float kdprev = 0.f;
#pragma unroll
                for (int i = 0; i < 8; ++i) {
                    const int t = tq * 8 + i;
                    const float d = b[i] + excl - rho;
                    const float ea = __expf(d), eb = __builtin_amdgcn_rcpf(ea);
                    const float qe = qs[i] * ea, ke = kk[i] * eb, kdv = ke * eBr;
                    const int addr = t * 256 + (((pc >> 3) ^ (t & 15)) << 4) + (pc & 7) * 2;
                    *(bf16_t*)(lds + SC_QE + addr) = (bf16_t)(pk2(qe, 0.f) & 0xffffu);
                    *(bf16_t*)(lds + SC_KE + addr) = (bf16_t)(pk2(ke, 0.f) & 0xffffu);
                    if (i & 1) kd[i >> 1] = pk2(kdprev, kdv); else kdprev = kdv;
                }
                uint4 kdw; kdw.x = kd[0]; kdw.y = kd[1]; kdw.z = kd[2]; kdw.w = kd[3];
                *(uint4*)(lds + SC_KDT + c * 64 + ((tq ^ ((c >> 2) & 3)) << 4)) = kdw;
                if (tq == 0) { *(float*)(lds + SC_ER + c * 4) = __expf(rho); *(float*)(lds + SC_EB + c * 4) = __expf(Btot); }
                if (tid < 256) {
                    const int dv = c;
                    unsigned short vv[8];
#pragma unroll
                    for (int i = 0; i < 8; ++i) vv[i] = *(const bf16_t*)(raw + SC_RAWV + tq * 1056 + i * 128 + dv * 2);
                    uint4 w; w.x = vv[0] | ((unsigned)vv[1] << 16); w.y = vv[2] | ((unsigned)vv[3] << 16); w.z = vv[4] | ((unsigned)vv[5] << 16); w.w = vv[6] | ((unsigned)vv[7] << 16);
                    *(uint4*)(lds + SC_VT + dv * 64 + ((tq ^ ((dv >> 2) & 3)) << 4)) = w;
                }
            }
            __syncthreads();
            if (wave < 2) {
                const int dvb = wave, sw4 = (r >> 2) & 3;
                const unsigned char* qrow = lds + SC_QE + r * 256;
                const unsigned char* vrow = lds + SC_VT + (dvb * 32 + r) * 64;
                bf16x8 qf[8];
#pragma unroll
                for (int k8 = 0; k8 < 8; ++k8) qf[k8] = *(const bf16x8*)(qrow + (((2 * k8 + h) ^ (r & 15)) << 4));
                f32x16 Y, Y2;
#pragma unroll
                for (int j = 0; j < 16; ++j) { Y[j] = 0.f; Y2[j] = 0.f; }
#pragma unroll
                for (int dkb = 0; dkb < 4; ++dkb) {
                    f32x4 er[4];
#pragma unroll
                    for (int g4 = 0; g4 < 4; ++g4) er[g4] = *(const f32x4*)(lds + SC_ER + (dkb * 32 + 8 * g4 + 4 * h) * 4);
                    unsigned pkd[8];
#pragma unroll
                    for (int g4 = 0; g4 < 4; ++g4) {
                        pkd[2 * g4] = pk2(S[dkb][4 * g4] * er[g4][0], S[dkb][4 * g4 + 1] * er[g4][1]);
                        pkd[2 * g4 + 1] = pk2(S[dkb][4 * g4 + 2] * er[g4][2], S[dkb][4 * g4 + 3] * er[g4][3]);
                    }
                    typedef unsigned u4 __attribute__((ext_vector_type(4)));
                    const u4 t0 = {pkd[0], pkd[1], pkd[2], pkd[3]}, t1 = {pkd[4], pkd[5], pkd[6], pkd[7]};
                    Y = __builtin_amdgcn_mfma_f32_32x32x16_bf16(__builtin_bit_cast(bf16x8, t0), qf[dkb * 2], Y, 0, 0, 0);
                    Y2 = __builtin_amdgcn_mfma_f32_32x32x16_bf16(__builtin_bit_cast(bf16x8, t1), qf[dkb * 2 + 1], Y2, 0, 0, 0);
                }
#pragma unroll
                for (int j = 0; j < 16; ++j) Ykeep[j] = Y[j] + Y2[j];
                bf16x8 kdf[8], vf2[2];
#pragma unroll
                for (int dkb = 0; dkb < 4; ++dkb)
#pragma unroll
                    for (int s2 = 0; s2 < 2; ++s2) kdf[dkb * 2 + s2] = *(const bf16x8*)(lds + SC_KDT + (dkb * 32 + r) * 64 + (((2 * s2 + h) ^ sw4) << 4));
#pragma unroll
                for (int s2 = 0; s2 < 2; ++s2) vf2[s2] = *(const bf16x8*)(vrow + (((2 * s2 + h) ^ sw4) << 4));
#pragma unroll
                for (int dkb = 0; dkb < 4; ++dkb) {
                    f32x4 eb[4];
#pragma unroll
                    for (int g4 = 0; g4 < 4; ++g4) eb[g4] = *(const f32x4*)(lds + SC_EB + (dkb * 32 + 8 * g4 + 4 * h) * 4);
#pragma unroll
                    for (int g4 = 0; g4 < 4; ++g4) { S[dkb][4 * g4] *= eb[g4][0]; S[dkb][4 * g4 + 1] *= eb[g4][1]; S[dkb][4 * g4 + 2] *= eb[g4][2]; S[dkb][4 * g4 + 3] *= eb[g4][3]; }
#pragma unroll
                    for (int s2 = 0; s2 < 2; ++s2) S[dkb] = __builtin_amdgcn_mfma_f32_32x32x16_bf16(kdf[dkb * 2 + s2], vf2[s2], S[dkb], 0, 0, 0);
                }
            } else if (wave < 4) {
                const int dvb = wave - 2, sw4 = (r >> 2) & 3;
                const unsigned char* qrow = lds + SC_QE + r * 256;
                const unsigned char* krow_ = lds + SC_KE + r * 256;
                const unsigned char* vrow = lds + SC_VT + (dvb * 32 + r) * 64;
                bf16x8 qf[8], kf[8];
#pragma unroll
                for (int k8 = 0; k8 < 8; ++k8) { const int ch = ((2 * k8 + h) ^ (r & 15)) << 4; kf[k8] = *(const bf16x8*)(krow_ + ch); qf[k8] = *(const bf16x8*)(qrow + ch); }
                uint2 vlo[2], vhi[2];
#pragma unroll
                for (int s2 = 0; s2 < 2; ++s2) { vlo[s2] = *(const uint2*)(vrow + (((2 * s2) ^ sw4) << 4) + 8 * h); vhi[s2] = *(const uint2*)(vrow + (((2 * s2 + 1) ^ sw4) << 4) + 8 * h); }
                f32x16 PT, PT2, Yi;
#pragma unroll
                for (int j = 0; j < 16; ++j) { PT[j] = 0.f; PT2[j] = 0.f; Yi[j] = 0.f; }
#pragma unroll
                for (int k8 = 0; k8 < 8; k8 += 2) {
                    PT = __builtin_amdgcn_mfma_f32_32x32x16_bf16(kf[k8], qf[k8], PT, 0, 0, 0);
                    PT2 = __builtin_amdgcn_mfma_f32_32x32x16_bf16(kf[k8 + 1], qf[k8 + 1], PT2, 0, 0, 0);
                }
                unsigned pp[8];
#pragma unroll
                for (int j = 0; j < 8; ++j) {
                    const int i0 = 2 * j, i1 = 2 * j + 1;
                    const int j0 = (i0 & 3) + 8 * (i0 >> 2) + 4 * h, j1 = (i1 & 3) + 8 * (i1 >> 2) + 4 * h;
                    pp[j] = pk2(j0 <= r ? PT[i0] + PT2[i0] : 0.f, j1 <= r ? PT[i1] + PT2[i1] : 0.f);
                }
#pragma unroll
                for (int s2 = 0; s2 < 2; ++s2) {
                    typedef unsigned u4 __attribute__((ext_vector_type(4)));
                    const u4 t0 = {pp[4 * s2], pp[4 * s2 + 1], pp[4 * s2 + 2], pp[4 * s2 + 3]};
                    const u4 t1 = {vlo[s2].x, vlo[s2].y, vhi[s2].x, vhi[s2].y};
                    Yi = __builtin_amdgcn_mfma_f32_32x32x16_bf16(__builtin_bit_cast(bf16x8, t1), __builtin_bit_cast(bf16x8, t0), Yi, 0, 0, 0);
                }
                float* yo = (float*)(lds + SC_YI) + (dvb * 16) * 64 + lane;
#pragma unroll
                for (int j = 0; j < 16; ++j) yo[j * 64] = Yi[j];
            }
            WAIT_VM0();
            __syncthreads();
        }
        if (wave < 2) {
            const size_t orow = (size_t)bl * TPB + scan_tok((NCH - 1) * 32 + r, dir);
            bf16_t* op = Od + orow * DI_ + hd * 128 + vh * 64 + wave * 32 + 4 * h;
#pragma unroll
            for (int g4 = 0; g4 < 4; ++g4) {
                    const float* yi = (const float*)(lds + SC_YI) + (wave * 16 + 4 * g4) * 64 + lane;
                    uint2 o; o.x = pk2(Ykeep[4 * g4] + yi[0], Ykeep[4 * g4 + 1] + yi[64]); o.y = pk2(Ykeep[4 * g4 + 2] + yi[128], Ykeep[4 * g4 + 3] + yi[192]);
                    *(uint2*)(op + 8 * g4) = o; }
        }
    }
}

__device__ void phase_combine(const Params& p) {
    const bf16_t* OF = (const bf16_t*)(p.ws + OFF_OF);
    const bf16_t* OB = (const bf16_t*)(p.ws + OFF_OB);
    bf16_t* GP = (bf16_t*)(p.ws + OFF_P1 + 4 * PLANE);
    const size_t total = (size_t)GROWS * DI_ / 8;
    const int tid_c = opaque_tid();
    for (size_t it = (size_t)blockIdx.x * NTH + tid_c; it < total; it += (size_t)gridDim.x * NTH) {
        const size_t e0 = it * 8;
        const int c = (int)(e0 & 2047);
        const uint4 a = *(const uint4*)(OF + e0), b = *(const uint4*)(OB + e0), gt = *(const uint4*)(GP + e0);
        const unsigned as[4] = {a.x, a.y, a.z, a.w}, bs[4] = {b.x, b.y, b.z, b.w}, gs[4] = {gt.x, gt.y, gt.z, gt.w};
        float o[8], ss = 0.f;
#pragma unroll
        for (int j = 0; j < 4; ++j) { o[2 * j] = bf_lo(as[j]) + bf_lo(bs[j]); o[2 * j + 1] = bf_hi(as[j]) + bf_hi(bs[j]); ss += o[2 * j] * o[2 * j] + o[2 * j + 1] * o[2 * j + 1]; }
        ss += __shfl_xor(ss, 1); ss += __shfl_xor(ss, 2); ss += __shfl_xor(ss, 4); ss += __shfl_xor(ss, 8);
        const float rstd = rsqrtf(ss * (1.0f / 128.f) + EPS);
        float y[8];
#pragma unroll
        for (int j = 0; j < 4; ++j) {
            y[2 * j] = o[2 * j] * rstd * p.hg_norm_g[c + 2 * j] * bf_lo(gs[j]);
            y[2 * j + 1] = o[2 * j + 1] * rstd * p.hg_norm_g[c + 2 * j + 1] * bf_hi(gs[j]);
        }
        uint4 r; r.x = pk2(y[0], y[1]); r.y = pk2(y[2], y[3]); r.z = pk2(y[4], y[5]); r.w = pk2(y[6], y[7]);
        *(uint4*)((bf16_t*)(p.ws + OFF_OF) + e0) = r;
    }
}

constexpr int AT_STAGE = 32768;
DI float rowmax16(const f32x16& s) {
    float m = fmaxf(fmaxf(s[0], s[1]), fmaxf(s[2], s[3]));
    m = fmaxf(m, fmaxf(fmaxf(s[4], s[5]), fmaxf(s[6], s[7])));
    m = fmaxf(m, fmaxf(fmaxf(s[8], s[9]), fmaxf(s[10], s[11])));
    m = fmaxf(m, fmaxf(fmaxf(s[12], s[13]), fmaxf(s[14], s[15])));
    return m;
}
DI void attn_issue(const bf16_t* gk, const bf16_t* gv, unsigned char* __restrict__ dst, int wave) {
#pragma unroll
    for (int i = 0; i < 2; ++i) {
        __builtin_amdgcn_global_load_lds((const unsigned*)(gk + (size_t)(i * 32) * DI_), (unsigned*)(dst + (i * 8 + wave) * 1024), 16, 0, 0);
        __builtin_amdgcn_global_load_lds((const unsigned*)(gv + (size_t)i * 64 * TPB), (unsigned*)(dst + 16384 + (i * 8 + wave) * 1024), 16, 0, 0);
    }
}
DI void attn_issue_half(const bf16_t* gk, const bf16_t* gv, unsigned char* __restrict__ dst, int wave, int i) {
    __builtin_amdgcn_global_load_lds((const unsigned*)(gk + (size_t)(i * 32) * DI_), (unsigned*)(dst + (i * 8 + wave) * 1024), 16, 0, 0);
    __builtin_amdgcn_global_load_lds((const unsigned*)(gv + (size_t)i * 64 * TPB), (unsigned*)(dst + 16384 + (i * 8 + wave) * 1024), 16, 0, 0);
}
DI void attn_read_k(const unsigned char* kp, int ph, int h, int ksw, bf16x8 (&kf)[4]) {
#pragma unroll
    for (int ks = 0; ks < 4; ++ks) kf[ks] = *(const bf16x8*)(kp + ((8 * ph + 2 * ks + h) ^ ksw) * 16);
}
DI void attn_read_v(const unsigned char* vp, int kb, int h, int vsw, bf16x8 (&vf)[8]) {
#pragma unroll
    for (int s2 = 0; s2 < 2; ++s2)
#pragma unroll
        for (int vb = 0; vb < 4; ++vb) vf[s2 * 4 + vb] = *(const bf16x8*)(vp + vb * 4096 + ((kb * 4 + 2 * s2 + h) ^ vsw) * 16);
}
DI f32x16 attn_qk(const bf16x8 (&kf)[4], const bf16x8 (&Qf)[4], const f32x16& NM) {
    f32x16 S = __builtin_amdgcn_mfma_f32_32x32x16_bf16(kf[0], Qf[0], NM, 0, 0, 0);
#pragma unroll
    for (int ks = 1; ks < 4; ++ks) S = __builtin_amdgcn_mfma_f32_32x32x16_bf16(kf[ks], Qf[ks], S, 0, 0, 0);
    return S;
}
DI void attn_softmax(f32x16& S, float mm_used, bool first, f32x16 (&O)[4], f32x16& NM, float& mm, float& ls, unsigned (&P)[8]) {
    float e[16];
#pragma unroll
    for (int j = 0; j < 16; ++j) e[j] = __builtin_amdgcn_exp2f(S[j]);
    float ps = ((e[0] + e[1]) + (e[2] + e[3])) + ((e[4] + e[5]) + (e[6] + e[7])) + (((e[8] + e[9]) + (e[10] + e[11])) + ((e[12] + e[13]) + (e[14] + e[15])));
    const float adj = mm_used - mm;
    if (first || __any(!(ps <= 4096.f) || adj != 0.f)) {
        float rm = rowmax16(S) + adj;
        rm = fmaxf(rm, __shfl_xor(rm, 32));
        const float dlt = first ? rm : fmaxf(rm, 0.f);
        const float al = first ? 1.0f : __builtin_amdgcn_exp2f(-dlt);
        mm += dlt; ls *= al;
        const float sub = dlt - adj, nm = -mm;
#pragma unroll
        for (int j = 0; j < 16; ++j) { e[j] = __builtin_amdgcn_exp2f(S[j] - sub); NM[j] = nm; }
        ps = ((e[0] + e[1]) + (e[2] + e[3])) + ((e[4] + e[5]) + (e[6] + e[7])) + (((e[8] + e[9]) + (e[10] + e[11])) + ((e[12] + e[13]) + (e[14] + e[15])));
#pragma unroll
        for (int i = 0; i < 4; ++i)
#pragma unroll
            for (int j = 0; j < 16; ++j) O[i][j] *= al;
    }
    ls += ps;
#pragma unroll
    for (int j = 0; j < 8; ++j) P[j] = pk2(e[2 * j], e[2 * j + 1]);
}
DI void attn_pv(const unsigned (&P)[8], const bf16x8 (&vf)[8], f32x16 (&O)[4]) {
#pragma unroll
    for (int s2 = 0; s2 < 2; ++s2) {
        typedef unsigned u4 __attribute__((ext_vector_type(4)));
        const u4 t0 = {P[4 * s2], P[4 * s2 + 1], P[4 * s2 + 2], P[4 * s2 + 3]};
        const bf16x8 pf = __builtin_bit_cast(bf16x8, t0);
#pragma unroll
        for (int vb = 0; vb < 4; ++vb) O[vb] = __builtin_amdgcn_mfma_f32_32x32x16_bf16(vf[s2 * 4 + vb], pf, O[vb], 0, 0, 0);
    }
}
DI void attn_tile(const unsigned char* __restrict__ sCur, const unsigned char* __restrict__ sNxt, unsigned char* __restrict__ dIss, bool has_next, bool last_wait0, bool issue,
                  const bf16_t* gk3, const bf16_t* gv3, int wave, bool first_tile, int pr, int ph, int h, int r, int ksw, int vsw,
                  const bf16x8 (&Qf)[4], f32x16 (&O)[4], f32x16& Snext, f32x16& NM, float& mm_n, float& mm, float& ls) {
    const unsigned char* vp = sCur + 16384 + r * 128;
    bf16x8 kf[4], vf[8];
    unsigned P[8];
    attn_read_k(sCur + (32 + pr) * 256, ph, h, ksw, kf);
    attn_read_v(vp, 0, h, vsw, vf);
    __builtin_amdgcn_sched_barrier(0);
    if (issue) attn_issue_half(gk3, gv3, dIss, wave, 0);
    f32x16 Sc = Snext; float mmc = mm_n;
    Snext = attn_qk(kf, Qf, NM); mm_n = mm;
    attn_softmax(Sc, mmc, first_tile, O, NM, mm, ls, P);
    attn_pv(P, vf, O);
    Sc = Snext; mmc = mm_n;
    attn_read_v(vp, 1, h, vsw, vf);
    attn_softmax(Sc, mmc, false, O, NM, mm, ls, P);
    attn_pv(P, vf, O);
    if (has_next) {
        if (issue) asm volatile("s_waitcnt vmcnt(6)" ::: "memory"); else if (!last_wait0) asm volatile("s_waitcnt vmcnt(4)" ::: "memory"); else asm volatile("s_waitcnt vmcnt(0)" ::: "memory");
        asm volatile("s_waitcnt lgkmcnt(0)" ::: "memory");
        __builtin_amdgcn_s_barrier();
        attn_read_k(sNxt + pr * 256, ph, h, ksw, kf);
        __builtin_amdgcn_sched_barrier(0);
        if (issue) attn_issue_half(gk3, gv3, dIss, wave, 1);
        Snext = attn_qk(kf, Qf, NM); mm_n = mm;
    }
}
__device__ void phase_attn(const Params& p, unsigned char* lds) {
    const int tid = opaque_tid(), lane = tid & 63, wave = __builtin_amdgcn_readfirstlane(tid >> 6), r = lane & 31, h = lane >> 5;
    const int qg = wave >> 1, ph = wave & 1;
    if (wave >= 4) __builtin_amdgcn_s_setprio(1);
    const bf16_t* Qb = (const bf16_t*)(p.ws + OFF_QB);
    const bf16_t* Kb = (const bf16_t*)(p.ws + OFF_KB);
    const bf16_t* Vt = (const bf16_t*)(p.ws + OFF_VT);
    const bf16_t* Gb = (const bf16_t*)(p.ws + OFF_GB);
    bf16_t* Y = (bf16_t*)(p.ws + OFF_Y2);
    const float lam = ((const float*)(p.ws + OFF_SCAL))[0];
    const int xcd = blockIdx.x & 7, lb = blockIdx.x >> 3, nl = gridDim.x >> 3;
    const int pr = (r & ~12) | ((r & 4) << 1) | ((r & 8) >> 1);
    const int kr0 = wave * 4 + (lane >> 4), kchunk = (lane & 15) ^ (kr0 & 15);
    const int vr0 = wave * 8 + (lane >> 3), vchunk = (lane & 7) ^ ((vr0 >> 1) & 7);
    const int vsw = (r >> 1) & 7, ksw = pr & 15;
    float* xch = (float*)(lds + 2 * AT_STAGE);
    constexpr int NT = TPB / 64;
    bf16x8 Qf[4];
#define ATT_COORDS(QQ, BL, HD, L0, GK, GV) const int pair_##BL = xcd * 8 + ((QQ) >> 5), BL = pair_##BL >> 4, HD = pair_##BL & 15, L0 = ((QQ) & 31) * 128 + qg * 32;          \
        const bf16_t* GK = Kb + ((size_t)BL * TPB + kr0) * DI_ + HD * 128 + kchunk * 8; const bf16_t* GV = Vt + ((size_t)(BL * NH + HD) * 128 + vr0) * TPB + vchunk * 8
#define ATT_LOADQ(BL, HD, L0) do { const bf16_t* qp_ = Qb + ((size_t)BL * SEQ + L0 + r) * DI_ + HD * 128 + 64 * ph + 8 * h;                                               \
        _Pragma("unroll") for (int ks = 0; ks < 4; ++ks) Qf[ks] = *(const bf16x8*)(qp_ + 16 * ks); } while (0)
    WAIT_VM0();
    if (lb < 256) { ATT_COORDS(lb, bl0, hd0, l00, gk0, gv0); attn_issue(gk0, gv0, lds, wave); attn_issue(gk0 + (size_t)64 * DI_, gv0 + 64, lds + AT_STAGE, wave); ATT_LOADQ(bl0, hd0, l00); }
    WAIT_VM0();
    __syncthreads();
    for (int q = lb; q < 256; q += nl) {
        ATT_COORDS(q, bl, hd, l0, gk, gv);
        f32x16 O[4];
#pragma unroll
        for (int i = 0; i < 4; ++i)
#pragma unroll
            for (int j = 0; j < 16; ++j) O[i][j] = 0.f;
        float mm = 0.f, ls = 0.f;
        attn_issue(gk + (size_t)128 * DI_, gv + 128, lds + 2 * AT_STAGE, wave);
        bf16x8 kf0[4];
        attn_read_k(lds + pr * 256, ph, h, ksw, kf0);
        f32x16 NM;
#pragma unroll
        for (int j = 0; j < 16; ++j) NM[j] = 0.f;
        f32x16 Snext = attn_qk(kf0, Qf, NM);
        float mm_n = mm;
        for (int kt = 0; kt < NT; ++kt) {
            const int sc = kt & 3, sn = (kt + 1) & 3, si = (kt + 3) & 3;
            attn_tile(lds + sc * AT_STAGE, lds + sn * AT_STAGE, lds + si * AT_STAGE, kt + 1 < NT, kt + 2 >= NT, kt + 3 < NT,
                      gk + (size_t)(kt + 3) * 64 * DI_, gv + (kt + 3) * 64, wave, kt == 0, pr, ph, h, r, ksw, vsw, Qf, O, Snext, NM, mm_n, mm, ls);
        }
        __syncthreads();
        if (q + nl < 256) { ATT_COORDS(q + nl, bln, hdn, l0n, gkn, gvn); (void)l0n; attn_issue(gkn, gvn, lds, wave); attn_issue(gkn + (size_t)64 * DI_, gvn + 64, lds + AT_STAGE, wave); }
        ls += __shfl_xor(ls, 32);
        const float inv = (ph ? lam : 1.0f) * __builtin_amdgcn_rcpf(ls);
        if (ph) {
#pragma unroll
            for (int vb = 0; vb < 4; ++vb)
#pragma unroll
                for (int j = 0; j < 16; ++j) xch[(qg * 64 + vb * 16 + j) * 64 + lane] = O[vb][j] * inv;
        }
        __syncthreads();
        if (!ph) {
            float ss = 0.f;
#pragma unroll
            for (int vb = 0; vb < 4; ++vb)
#pragma unroll
                for (int j = 0; j < 16; ++j) { const float o = O[vb][j] * inv - xch[(qg * 64 + vb * 16 + j) * 64 + lane]; O[vb][j] = o; ss += o * o; }
            ss += __shfl_xor(ss, 32);
            const float rstd = rsqrtf(ss * (1.0f / 128.f) + EPS) * (1.0f - LAMBDA_INIT);
            const size_t rowoff = ((size_t)bl * SEQ + l0 + r) * DI_ + hd * 128;
#pragma unroll
            for (int vb = 0; vb < 4; ++vb)
#pragma unroll
                for (int g4 = 0; g4 < 4; ++g4) {
                    const int v = vb * 32 + 8 * g4 + 4 * h;
                    const uint2 gt = *(const uint2*)(Gb + rowoff + v);
                    const f32x4 sg = *(const f32x4*)(p.subln_g + v);
                    const float y0 = O[vb][4 * g4] * rstd * sg[0] * siluf_(bf_lo(gt.x)), y1 = O[vb][4 * g4 + 1] * rstd * sg[1] * siluf_(bf_hi(gt.x));
                    const float y2 = O[vb][4 * g4 + 2] * rstd * sg[2] * siluf_(bf_lo(gt.y)), y3 = O[vb][4 * g4 + 3] * rstd * sg[3] * siluf_(bf_hi(gt.y));
                    uint2 o; o.x = pk2(y0, y1); o.y = pk2(y2, y3);
                    *(uint2*)(Y + rowoff + v) = o;
                }
        }
        __builtin_amdgcn_sched_barrier(0);
        if (q + nl < 256) { ATT_COORDS(q + nl, blq, hdq, l0q, gkq, gvq); (void)gkq; (void)gvq; ATT_LOADQ(blq, hdq, l0q); }
        WAIT_VM0();
        __syncthreads();
    }
    __builtin_amdgcn_s_setprio(0);
}

__device__ void phase_final(const Params& p) {
    const int tid_ = opaque_tid(), lane = tid_ & 63, wave = tid_ >> 6;
    for (int R = blockIdx.x * NWV + wave; R < NB * SEQ; R += gridDim.x * NWV) {
        float* row = p.out + (size_t)R * D;
        float4 v[4];
        float ss = 0.f;
#pragma unroll
        for (int i = 0; i < 4; ++i) { v[i] = *(const float4*)(row + (i * 64 + lane) * 4); ss += v[i].x * v[i].x + v[i].y * v[i].y + v[i].z * v[i].z + v[i].w * v[i].w; }
        ss = wave_sum(ss);
        const float rstd = rsqrtf(ss * (1.0f / D) + EPS);
#pragma unroll
        for (int i = 0; i < 4; ++i) {
            const int e = (i * 64 + lane) * 4;
            const float4 gg = *(const float4*)(p.final_g + e);
            float4 o; o.x = v[i].x * rstd * gg.x; o.y = v[i].y * rstd * gg.y; o.z = v[i].z * rstd * gg.z; o.w = v[i].w * rstd * gg.w;
            *(float4*)(row + e) = o;
        }
    }
}


#define XB_TMO      128
#define XB_XCNT(j)  (256  + 64 * (j))
#define XB_XSUB(j)  (1280 + 64 * (j))
#define XB_XGEN(j)  (2304 + 64 * (j))
#define XB_TOP      3328
#define XB_TOPGEN   3392
#define XCD_BAR_WORDS 3456
#define XB_SPIN_CAP (1u << 22)
#define LAS __attribute__((address_space(3)))
DI unsigned xb_ld(unsigned* p)              { return __hip_atomic_load(p, __ATOMIC_RELAXED, __HIP_MEMORY_SCOPE_AGENT); }
DI unsigned xb_add(unsigned* p, unsigned v) { return __hip_atomic_fetch_add(p, v, __ATOMIC_RELAXED, __HIP_MEMORY_SCOPE_AGENT); }
DI unsigned xb_xcc_id() { return (unsigned)__builtin_amdgcn_s_getreg((3 << 11) | 20) & 0xFu; }
#define XB_SPIN(cond, bar) do { unsigned _sp = 0; while (cond) { __builtin_amdgcn_s_sleep(1); \
    if ((++_sp & 255u) == 0u) { if (xb_ld(&(bar)[XB_TMO])) break; if (_sp > XB_SPIN_CAP) { atomicAdd(&(bar)[XB_TMO], 1u); break; } } } } while (0)
struct XcdBarrier { unsigned* bar; unsigned x; volatile LAS unsigned* st; };
DI XcdBarrier xcd_barrier_post(unsigned* bar, volatile LAS unsigned* st) {
    XcdBarrier b; b.bar = bar; b.x = xb_xcc_id(); b.st = st;
    if (threadIdx.x == 0) (void)xb_add(&bar[XB_XCNT(b.x)], 1u);
    return b;
}
DI void xcd_barrier_complete(unsigned* bar, unsigned x, unsigned& nloc, unsigned& nx) {
    const unsigned G = gridDim.x * gridDim.y * gridDim.z;
    unsigned sum, cnt, mine, sp = 0u;
    for (;;) {
        sum = 0u; cnt = 0u; mine = 0u;
#pragma unroll
        for (unsigned j = 0; j < 16; ++j) { const unsigned c = xb_ld(&bar[XB_XCNT(j)]); sum += c; cnt += (c > 0u) ? 1u : 0u; mine = (j == x) ? c : mine; }
        if (sum == G) break;
        __builtin_amdgcn_s_sleep(1);
        if ((++sp & 255u) == 0u) { if (xb_ld(&bar[XB_TMO])) break; if (sp > XB_SPIN_CAP) { atomicAdd(&bar[XB_TMO], 1u); break; } }
    }
    nloc = mine > 0u ? mine : 1u; nx = cnt > 0u ? cnt : 1u;
}
DI void xcd_barrier(const XcdBarrier& b) {
    asm volatile("s_waitcnt vmcnt(0)" ::: "memory");
    __syncthreads();
    if (threadIdx.x == 0) {
        unsigned* bar = b.bar;
        __builtin_amdgcn_s_waitcnt(0);
        unsigned nloc = b.st[0], nx = b.st[1];
        if (nloc == 0u) { xcd_barrier_complete(bar, b.x, nloc, nx); b.st[0] = nloc; b.st[1] = nx; }
        const unsigned old = xb_add(&bar[XB_XSUB(b.x)], 1u);
        const unsigned gen = old / nloc;
        if (old + 1u == (gen + 1u) * nloc) {
            __builtin_amdgcn_fence(__ATOMIC_RELEASE, "agent");
            asm volatile("s_waitcnt vmcnt(0)" ::: "memory");
            const unsigned og = xb_add(&bar[XB_TOP], 1u);
            const unsigned tg = og / nx;
            if (og + 1u == (tg + 1u) * nx) xb_add(&bar[XB_TOPGEN], 1u);
            else XB_SPIN(xb_ld(&bar[XB_TOPGEN]) == tg, bar);
            __builtin_amdgcn_fence(__ATOMIC_ACQUIRE, "agent");
            xb_add(&bar[XB_XGEN(b.x)], 1u);
            asm volatile("s_waitcnt vmcnt(0)" ::: "memory");
        } else {
            XB_SPIN(xb_ld(&bar[XB_XGEN(b.x)]) == gen, bar);
            __builtin_amdgcn_fence(__ATOMIC_ACQUIRE, "agent");
            asm volatile("s_waitcnt vmcnt(0)" ::: "memory");
        }
    }
    __syncthreads();
}
constexpr size_t OFF_BAR = 524288;

constexpr int N_PHASES = 18;
constexpr int LDS_BYTES = 3 * G_STAGEB;
#ifndef PH_MASK
#define PH_MASK 0xffffffffu
#endif
#define EN(k) ((PH_MASK >> (k)) & 1u)
#ifndef REP_MASK
#define REP_MASK 0u
#endif
#define REP(k) ((REP_MASK >> (k)) & 1u)
#define PHASE(k, bit, ...) if (p.ph_begin <= (k) && (k) < p.ph_end) { if (EN(bit)) { __VA_ARGS__; } if (REP(bit)) { __VA_ARGS__; } if ((k) + 1 < p.ph_end && (k) != 5 && (k) != 13) { if ((k) == 0) cg::this_grid().sync(); else xcd_barrier(xb); } }
__global__ void __launch_bounds__(512, 2) fwd_megakernel(Params p) {
    __shared__ __attribute__((aligned(1024))) unsigned char lds[LDS_BYTES + 16];
    unsigned char* ws = p.ws;
    volatile LAS unsigned* xst = (volatile LAS unsigned*)(lds + LDS_BYTES);
    if (threadIdx.x == 0) { xst[0] = 0u; xst[1] = 0u; xst[2] = 0u; xst[3] = 0u; }
    __syncthreads();
    XcdBarrier xb = xcd_barrier_post((unsigned*)(ws + OFF_BAR), xst);
    PHASE(0, 0, phase_prologue(p, (float*)lds))
    PHASE(1, 1, phase_modulate(p, 0, p.x, p.ctx, (unsigned char*)p.out, HG_STRIDE))
#pragma unroll 1
    for (int g = 0; g < 2; ++g) {
        PHASE(2 + 4 * g, 2, EpiPlanes e{(bf16_t*)(ws + OFF_P1), (const float*)(ws + OFF_LB)}; gemmh_phase((const bf16_t*)((unsigned char*)p.out + (size_t)g * HG_STRIDE), (const bf16_t*)(ws + OFF_WT_A), GROWS, 10240, 1024, e, lds))
        PHASE(3 + 4 * g, 3, phase_scan(p, lds))
        PHASE(4 + 4 * g, 4, phase_combine(p))
        PHASE(5 + 4 * g, 5, EpiOut0 e{p.x, p.ctx, (const float*)(ws + OFF_MOD), p.out, (float*)(ws + OFF_X1CTX), g}; gemm_phase((const bf16_t*)(ws + OFF_OF), (const bf16_t*)(ws + OFF_WT_B), GROWS, 1024, 2048, e, lds))
    }
    PHASE(10, 6, phase_convert_da(p, (float*)lds); phase_modulate(p, 1, p.out, (const float*)(ws + OFF_X1CTX), ws + OFF_H1, (size_t)GROWS * D * 2))
#pragma unroll 1
    for (int g = 0; g < 2; ++g) {
        PHASE(11 + 3 * g, 7, EpiDA e{(bf16_t*)(ws + OFF_QB), (bf16_t*)(ws + OFF_KB), (bf16_t*)(ws + OFF_VT), (bf16_t*)(ws + OFF_GB)}; gemmh_phase((const bf16_t*)(ws + OFF_H1 + (size_t)g * GROWS * D * 2), (const bf16_t*)(ws + OFF_WT_A), GROWS, 8192, 1024, e, lds))
        PHASE(12 + 3 * g, 8, phase_attn(p, lds))
        PHASE(13 + 3 * g, 9, EpiOut1 e{(const float*)(ws + OFF_MOD) + 9 * 3072, p.out, g}; gemm_phase((const bf16_t*)(ws + OFF_Y2), (const bf16_t*)(ws + OFF_WT_B), GLAT, 1024, 2048, e, lds))
    }
    PHASE(17, 10, phase_final(p))
}

extern "C" void kernel_launch(void* const* d_in, const int* in_sizes, int n_in, void* d_out, int out_size, void* d_ws, size_t ws_size, hipStream_t stream) {
    if (ws_size < WS_NEED) { fprintf(stderr, "workspace too small: %zu < %zu\n", ws_size, (size_t)WS_NEED); return; }
    static int grid_blocks = 0;
    if (!grid_blocks) {
        int dev = 0, cus = 0, per_cu = 0;
        hipGetDevice(&dev);
        hipDeviceGetAttribute(&cus, hipDeviceAttributeMultiprocessorCount, dev);
        hipOccupancyMaxActiveBlocksPerMultiprocessor(&per_cu, fwd_megakernel, NTH, 0);
        if (per_cu > 1) per_cu = 1;
        grid_blocks = cus * per_cu;
        if (grid_blocks < 8) grid_blocks = 8;
        grid_blocks &= ~7;
    }
    hipMemsetAsync((unsigned char*)d_ws + OFF_BAR, 0, XCD_BAR_WORDS * sizeof(unsigned), stream);
    Params p{};
    const float** f = (const float**)&p;
    for (int i = 0; i < 19; ++i) f[i] = (const float*)d_in[i];
    p.out = (float*)d_out; p.ws = (unsigned char*)d_ws;
#if MULTI_LAUNCH
    for (int ph = 0; ph < N_PHASES; ++ph) { p.ph_begin = ph; p.ph_end = ph + 1; hipLaunchKernelGGL(fwd_megakernel, dim3(grid_blocks), dim3(NTH), 0, stream, p); }
#else
    p.ph_begin = 0; p.ph_end = N_PHASES;
    void* args[] = {&p};
    hipError_t e = hipLaunchCooperativeKernel((void*)fwd_megakernel, dim3(grid_blocks), dim3(NTH), args, 0, stream);
    if (e != hipSuccess) fprintf(stderr, "cooperative launch failed: %s (grid %d)\n", hipGetErrorString(e), grid_blocks);
#endif
}
```

```cpp
#include <hip/hip_runtime.h>
#include <hip/hip_cooperative_groups.h>
#include <stdint.h>
#include <stdio.h>
namespace cg = cooperative_groups;

#ifndef MULTI_LAUNCH
#define MULTI_LAUNCH 0
#endif

typedef unsigned short bf16_t;
typedef short bf16x8 __attribute__((ext_vector_type(8)));
typedef float f32x4 __attribute__((ext_vector_type(4)));
typedef float f32x16 __attribute__((ext_vector_type(16)));
typedef __bf16 bf2_t __attribute__((ext_vector_type(2)));
typedef float f2_t __attribute__((ext_vector_type(2)));
#define DI __device__ __forceinline__
constexpr int NTH = 512, NWV = 8;

constexpr int D = 1024, NB = 8, SEQ = 4096, CTX = 256, TPB = SEQ + CTX  ;
constexpr int DI_ = 2048, NH = 16;
constexpr int GB_ = 4;
constexpr int GROWS = GB_ * TPB;
constexpr int GLAT = GB_ * SEQ;
constexpr float EPS = 1e-6f;
constexpr float LAMBDA_INIT = 0.35550906759f;
constexpr float QSCALE = 0.125f * 1.4426950408889634f;

constexpr size_t OFF_MOD = 0;
constexpr size_t OFF_LB = 262144;
constexpr size_t OFF_SCAL = 262144 + 16384;
constexpr size_t OFF_WT_A = 1048576;
constexpr size_t OFF_WT_B = OFF_WT_A + 20971520;
constexpr size_t OFF_X1CTX = OFF_WT_B + 4194304;
constexpr size_t OFF_BIG = OFF_X1CTX + 8388608;
constexpr size_t PLANE = (size_t)GROWS * DI_ * 2;
constexpr size_t OFF_P1 = OFF_BIG;
constexpr size_t OFF_OF = OFF_P1 + 5 * PLANE;
constexpr size_t OFF_OB = OFF_OF + PLANE;
constexpr size_t WS_NEED0 = OFF_OB + PLANE;
constexpr size_t OFF_H1 = OFF_BIG;
constexpr size_t OFF_QB = OFF_H1 + (size_t)NB * TPB * D * 2;
constexpr size_t OFF_KB = OFF_QB + (size_t)GLAT * DI_ * 2;
constexpr size_t OFF_VT = OFF_KB + PLANE;
constexpr size_t OFF_GB = OFF_VT + PLANE;
constexpr size_t OFF_Y2 = OFF_GB + (size_t)GLAT * DI_ * 2;
constexpr size_t WS_NEED1 = OFF_Y2 + (size_t)GLAT * DI_ * 2;
constexpr size_t WS_NEED = WS_NEED0 > WS_NEED1 ? WS_NEED0 : WS_NEED1;
constexpr size_t HG_STRIDE = 67108864;

struct Params {
    const float *x, *c, *ctx, *c_ctx, *w_ada, *b_ada, *norm_g, *hg_w_in, *hg_lb, *hg_norm_g, *hg_w_out;
    const float *da_w_in, *lq1, *lk1, *lq2, *lk2, *subln_g, *da_w_out, *final_g;
    float* out;
    unsigned char* ws;
    int ph_begin, ph_end;
};

DI unsigned pk2(float a, float b) { f2_t v = {a, b}; bf2_t r = __builtin_convertvector(v, bf2_t); return __builtin_bit_cast(unsigned, r); }
DI float bf_lo(unsigned u) { return __uint_as_float(u << 16); }
DI float bf_hi(unsigned u) { return __uint_as_float(u & 0xffff0000u); }
DI float sigmoidf_(float z) { return __builtin_amdgcn_rcpf(1.0f + __builtin_amdgcn_exp2f(-1.4426950408889634f * z)); }
DI float siluf_(float z) { return z * __builtin_amdgcn_rcpf(1.0f + __builtin_amdgcn_exp2f(-1.4426950408889634f * z)); }
typedef float f32x4nt __attribute__((ext_vector_type(4)));
typedef unsigned u32x4nt __attribute__((ext_vector_type(4)));
DI float4 nt_loadf4(const float* p) { const f32x4nt v = __builtin_nontemporal_load((const f32x4nt*)p); float4 r; r.x = v[0]; r.y = v[1]; r.z = v[2]; r.w = v[3]; return r; }
DI uint4 nt_loadu4(const void* p) { const u32x4nt v = __builtin_nontemporal_load((const u32x4nt*)p); uint4 r; r.x = v[0]; r.y = v[1]; r.z = v[2]; r.w = v[3]; return r; }
DI int opaque_tid() { int t = threadIdx.x; asm volatile("" : "+v"(t)); return t; }
template <int CTRL> DI float qperm(float v) { return __int_as_float(__builtin_amdgcn_mov_dpp(__float_as_int(v), CTRL, 0xF, 0xF, true)); }
DI float wave_sum(float v) {
#pragma unroll
    for (int o = 32; o >= 1; o >>= 1) v += __shfl_xor(v, o);
    return v;
}

DI int perm_row(int n, int mode) {
    if (mode == 0 || n >= 4096) return n;
    const int base = n & ~127, e = n & 127;
    const int p = e >> 6, a = (e >> 5) & 1, s2 = (e >> 4) & 1, i = e & 15;
    return base + 64 * p + 32 * a + 2 * i + s2;
}
__device__ void transpose_tile(const float* __restrict__ W, int K, int N, int tk, int tn, bf16_t* __restrict__ Wt, int mode, float* lds) {
    const int tid = opaque_tid();
    const int k0 = tk * 64, n0 = tn * 64;
#pragma unroll
    for (int i = 0; i < 1024 / NTH; ++i) {
        const int idx = tid + i * NTH, kr = idx >> 4, c4 = idx & 15;
        const float4 v = *(const float4*)(W + (size_t)(k0 + kr) * N + n0 + c4 * 4);
        float* d = lds + kr * 65 + c4 * 4;
        d[0] = v.x; d[1] = v.y; d[2] = v.z; d[3] = v.w;
    }
    __syncthreads();
    {
        const int idx = tid, nr = idx >> 3, kc = idx & 7;
        float f[8];
#pragma unroll
        for (int j = 0; j < 8; ++j) f[j] = lds[(kc * 8 + j) * 65 + nr];
        uint4 o; o.x = pk2(f[0], f[1]); o.y = pk2(f[2], f[3]); o.z = pk2(f[4], f[5]); o.w = pk2(f[6], f[7]);
        *(uint4*)(Wt + (size_t)perm_row(n0 + nr, mode) * K + k0 + kc * 8) = o;
    }
    __syncthreads();
}

__device__ void mod_item(const Params& p, int item, float* lds) {
    const int tid = opaque_tid(), lane = tid & 63, wave = tid >> 6;
    const int layer = item / 48, j = (item % 48) * 64 + lane;
    for (int idx = tid; idx < 9 * 1024; idx += NTH) {
        const int r = idx >> 10, k = idx & 1023;
        const float cv = r < 8 ? p.c[r * 1024 + k] : p.c_ctx[k];
        lds[idx] = siluf_(cv);
    }
    __syncthreads();
    float acc[9];
#pragma unroll
    for (int r = 0; r < 9; ++r) acc[r] = 0.f;
    const float* w = p.w_ada + (size_t)layer * 1024 * 3072 + (size_t)(wave * 128) * 3072 + j;
#pragma unroll 8
    for (int k = 0; k < 128; ++k) {
        const float wv = w[(size_t)k * 3072];
#pragma unroll
        for (int r = 0; r < 9; ++r) acc[r] += lds[r * 1024 + wave * 128 + k] * wv;
    }
    __syncthreads();
    float* part = lds + 9 * 1024;
#pragma unroll
    for (int r = 0; r < 9; ++r) part[(wave * 9 + r) * 64 + lane] = acc[r];
    __syncthreads();
    float* MOD = (float*)(p.ws + OFF_MOD);
    for (int idx = tid; idx < 9 * 64; idx += NTH) {
        const int r = idx >> 6, l = idx & 63, jj = (item % 48) * 64 + l;
        float sum = 0.f;
#pragma unroll
        for (int wv = 0; wv < 8; ++wv) sum += part[(wv * 9 + r) * 64 + l];
        MOD[(layer * 9 + r) * 3072 + jj] = sum + p.b_ada[layer * 3072 + jj];
    }
    __syncthreads();
}

__device__ void misc_item(const Params& p) {
    const int tid = opaque_tid();
    float* LB = (float*)(p.ws + OFF_LB);
    for (int idx = tid; idx < 2 * 2048; idx += NTH) {
        const float l0 = p.hg_lb[idx], l1 = p.hg_lb[2 * 2048 + idx];
        LB[idx] = 1.0f / (1.0f + __expf(l1 - l0));
    }
    if (tid == 0) {
        float s1 = 0.f, s2 = 0.f;
        for (int i = 0; i < 64; ++i) { s1 += p.lq1[i] * p.lk1[i]; s2 += p.lq2[i] * p.lk2[i]; }
        ((float*)(p.ws + OFF_SCAL))[0] = expf(s1) - expf(s2) + LAMBDA_INIT;
    }
}

__device__ void phase_prologue(const Params& p, float* lds) {
    const int n_items = 97 + 2560 + 512;
    for (int it = blockIdx.x; it < n_items; it += gridDim.x) {
        if (it < 96) mod_item(p, it, lds);
        else if (it == 96) misc_item(p);
        else if (it < 97 + 2560) { const int t = it - 97; transpose_tile(p.hg_w_in, 1024, 10240, t / 160, t % 160, (bf16_t*)(p.ws + OFF_WT_A), 0, lds); }
        else { const int t = it - 97 - 2560; transpose_tile(p.hg_w_out, 2048, 1024, t / 16, t % 16, (bf16_t*)(p.ws + OFF_WT_B), 0, lds); }
    }
}
__device__ void phase_convert_da(const Params& p, float* lds) {
    const int n_items = 2048 + 512;
    for (int it = blockIdx.x; it < n_items; it += gridDim.x) {
        if (it < 2048) transpose_tile(p.da_w_in, 1024, 8192, it / 128, it % 128, (bf16_t*)(p.ws + OFF_WT_A), 1, lds);
        else { const int t = it - 2048; transpose_tile(p.da_w_out, 2048, 1024, t / 16, t % 16, (bf16_t*)(p.ws + OFF_WT_B), 0, lds); }
    }
}

__device__ void phase_modulate(const Params& p, int layer, const float* lat, const float* ctxsrc, unsigned char* hbase, size_t hstride) {
    const int tid_ = opaque_tid(), lane = tid_ & 63, wave = tid_ >> 6;
    const float* MOD = (const float*)(p.ws + OFF_MOD);
    const float* g = p.norm_g + layer * 1024;
    for (int R = blockIdx.x * NWV + wave; R < NB * TPB; R += gridDim.x * NWV) {
        const int b = R / TPB, t = R % TPB;
        const float* src = t < CTX ? ctxsrc + ((size_t)b * CTX + t) * D : lat + ((size_t)b * SEQ + (t - CTX)) * D;
        const float* mrow = MOD + (size_t)(layer * 9 + (t < CTX ? 8 : b)) * 3072;
        float4 v[4];
        float ss = 0.f;
#pragma unroll
        for (int i = 0; i < 4; ++i) { v[i] = nt_loadf4(src + (i * 64 + lane) * 4); ss += v[i].x * v[i].x + v[i].y * v[i].y + v[i].z * v[i].z + v[i].w * v[i].w; }
        ss = wave_sum(ss);
        const float rstd = rsqrtf(ss * (1.0f / D) + EPS);
        bf16_t* dst = (bf16_t*)(hbase + (size_t)(b / GB_) * hstride) + ((size_t)(b % GB_) * TPB + t) * D;
#pragma unroll
        for (int i = 0; i < 4; ++i) {
            const int e = (i * 64 + lane) * 4;
            const float4 gg = *(const float4*)(g + e), sh = *(const float4*)(mrow + e), sc = *(const float4*)(mrow + 1024 + e);
            const float h0 = v[i].x * rstd * gg.x * (1.f + sc.x) + sh.x, h1 = v[i].y * rstd * gg.y * (1.f + sc.y) + sh.y;
            const float h2 = v[i].z * rstd * gg.z * (1.f + sc.z) + sh.z, h3 = v[i].w * rstd * gg.w * (1.f + sc.w) + sh.w;
            uint2 o; o.x = pk2(h0, h1); o.y = pk2(h2, h3);
            *(uint2*)(dst + e) = o;
        }
    }
}

#define WAIT_VM0() asm volatile("s_waitcnt vmcnt(0)" ::: "memory")
constexpr int G_ABYTES = 256 * 128, G_BBYTES = 128 * 128, G_STAGEB = G_ABYTES + G_BBYTES;
DI void gemm_issue(const bf16_t* ga, const bf16_t* gb, int K, unsigned char* __restrict__ dst, int wave) {
#pragma unroll
    for (int i = 0; i < 4; ++i) __builtin_amdgcn_global_load_lds((const unsigned*)(ga + (size_t)i * 64 * K), (unsigned*)(dst + (i * 8 + wave) * 1024), 16, 0, 0);
#pragma unroll
    for (int i = 0; i < 2; ++i) __builtin_amdgcn_global_load_lds((const unsigned*)(gb + (size_t)i * 64 * K), (unsigned*)(dst + G_ABYTES + (i * 8 + wave) * 1024), 16, 0, 0);
}
DI void gemm_data(const unsigned char* __restrict__ sA, unsigned char* __restrict__ dNext, bool issue, const bf16_t* ga2, const bf16_t* gb2, int K, int wave,
                  int wm, int wn, int fr, int fq, int rsw, bf16x8 (&af)[2][4], bf16x8 (&bfr)[2][4]) {
    const unsigned char* sB = sA + G_ABYTES;
#pragma unroll
    for (int ks = 0; ks < 2; ++ks)
#pragma unroll
        for (int i = 0; i < 4; ++i) {
            af[ks][i] = *(const bf16x8*)(sA + (wm * 64 + i * 16 + fr) * 128 + ((ks * 4 + fq) ^ rsw) * 16);
            bfr[ks][i] = *(const bf16x8*)(sB + (wn * 64 + i * 16 + fr) * 128 + ((ks * 4 + fq) ^ rsw) * 16);
        }
    __builtin_amdgcn_sched_barrier(0);
    if (issue) gemm_issue(ga2, gb2, K, dNext, wave);
}
DI void gemm_mfma(const bf16x8 (&af)[2][4], const bf16x8 (&bfr)[2][4], bool swapped, f32x4 (&acc)[4][4]) {
#pragma unroll
    for (int ks = 0; ks < 2; ++ks) {
        if (!swapped) {
#pragma unroll
            for (int i = 0; i < 4; ++i)
#pragma unroll
                for (int j = 0; j < 4; ++j) acc[i][j] = __builtin_amdgcn_mfma_f32_16x16x32_bf16(bfr[ks][j], af[ks][i], acc[i][j], 0, 0, 0);
        } else {
#pragma unroll
            for (int i = 0; i < 4; ++i)
#pragma unroll
                for (int j = 0; j < 4; ++j) acc[i][j] = __builtin_amdgcn_mfma_f32_16x16x32_bf16(af[ks][i], bfr[ks][j], acc[i][j], 0, 0, 0);
        }
    }
}
template <int HALF>
DI void gemm_kloop(unsigned char* lds, int& stg, int KT, bool have_next, const bf16_t* ga, const bf16_t* gb, const bf16_t* ga1, const bf16_t* gb1, int K, int wave,
                   int wm, int wn, int fr, int fq, int rsw, bool swapped, f32x4 (&acc)[4][4]) {
    for (int kt = 0; kt < KT; ++kt) {
        bf16x8 af[2][4], bfr[2][4];
        const int s3 = stg >= 1 ? stg - 1 : 2;
        const bool in_tile = kt + 2 < KT, issue = in_tile || have_next;
        const bf16_t* pa = in_tile ? ga + (kt + 2) * 64 : ga1 + (kt + 2 - KT) * 64;
        const bf16_t* pb = in_tile ? gb + (kt + 2) * 64 : gb1 + (kt + 2 - KT) * 64;
        if (HALF == 0) {
            gemm_data(lds + stg * G_STAGEB, lds + s3 * G_STAGEB, issue, pa, pb, K, wave, wm, wn, fr, fq, rsw, af, bfr);
            asm volatile("s_waitcnt lgkmcnt(0)" ::: "memory");
            __builtin_amdgcn_s_barrier();
            gemm_mfma(af, bfr, swapped, acc);
            if (issue) asm volatile("s_waitcnt vmcnt(6)" ::: "memory"); else asm volatile("s_waitcnt vmcnt(0)" ::: "memory");
            __builtin_amdgcn_s_barrier();
        } else {
            __builtin_amdgcn_s_barrier();
            gemm_data(lds + stg * G_STAGEB, lds + s3 * G_STAGEB, issue, pa, pb, K, wave, wm, wn, fr, fq, rsw, af, bfr);
            if (issue) asm volatile("s_waitcnt vmcnt(6)" ::: "memory"); else asm volatile("s_waitcnt vmcnt(0)" ::: "memory");
            asm volatile("s_waitcnt lgkmcnt(0)" ::: "memory");
            __builtin_amdgcn_s_barrier();
            gemm_mfma(af, bfr, swapped, acc);
        }
        stg = stg == 2 ? 0 : stg + 1;
    }
}
struct TileCur { int st, tt; };
template <class Epi>
DI bool gemm_next_tile(TileCur& c, int& m0, int& n0, const Epi& epi, int SNn, int nsuper, int lb, int nl) {
    for (;;) {
        if (c.st >= nsuper) return false;
        const int sm = c.st / SNn, sn = c.st % SNn;
        m0 = (sm * 4 + (c.tt & 3)) * 256; n0 = (sn * 8 + (c.tt >> 2)) * 128;
        c.tt += nl;
        if (c.tt >= 32) { c.tt = lb; c.st += 8; }
        if (!epi.skip(m0, n0)) return true;
    }
}
template <class Epi>
__device__ void gemm_phase(const bf16_t* __restrict__ A, const bf16_t* __restrict__ Bt, int M, int N, int K, const Epi& epi, unsigned char* lds) {
    const int tid = opaque_tid(), lane = tid & 63, wave = __builtin_amdgcn_readfirstlane(tid >> 6), wm = wave >> 1, wn = wave & 1;
    const int fr = lane & 15, fq = lane >> 4;
    const int MT = M / 256, NT = N / 128, SMn = MT / 4, SNn = NT / 8, nsuper = SMn * SNn;
    const int xcd = blockIdx.x & 7, lb = blockIdx.x >> 3, nl = gridDim.x >> 3;
    const int KT = K / 64;
    const int rl = wave * 8 + (lane >> 3), lchunk = (lane & 7) ^ ((rl >> 1) & 7);
    const int rsw = (fr >> 1) & 7;
    TileCur cur{xcd, lb};
    int m0, n0, m1 = 0, n1 = 0;
    bool have = gemm_next_tile(cur, m0, n0, epi, SNn, nsuper, lb, nl);
    WAIT_VM0();
    __syncthreads();
    int stg = 0;
    if (have) {
        const bf16_t* ga = A + (size_t)(m0 + rl) * K + lchunk * 8;
        const bf16_t* gb = Bt + (size_t)(n0 + rl) * K + lchunk * 8;
        gemm_issue(ga, gb, K, lds, wave);
        gemm_issue(ga + 64, gb + 64, K, lds + G_STAGEB, wave);
        asm volatile("s_waitcnt vmcnt(6)" ::: "memory");
    }
    __syncthreads();
    const int half = wave >> 2;
    if (half) __builtin_amdgcn_s_setprio(1);
    while (have) {
        const bool have_next = gemm_next_tile(cur, m1, n1, epi, SNn, nsuper, lb, nl);
        const bool swapped = epi.swapped(n0);
        f32x4 acc[4][4];
#pragma unroll
        for (int i = 0; i < 4; ++i)
#pragma unroll
            for (int j = 0; j < 4; ++j) acc[i][j] = (f32x4){0.f, 0.f, 0.f, 0.f};
        const bf16_t* ga = A + (size_t)(m0 + rl) * K + lchunk * 8;
        const bf16_t* gb = Bt + (size_t)(n0 + rl) * K + lchunk * 8;
        const bf16_t* ga1 = A + (size_t)(m1 + rl) * K + lchunk * 8;
        const bf16_t* gb1 = Bt + (size_t)(n1 + rl) * K + lchunk * 8;
        if (half == 0) gemm_kloop<0>(lds, stg, KT, have_next, ga, gb, ga1, gb1, K, wave, wm, wn, fr, fq, rsw, swapped, acc);
        else gemm_kloop<1>(lds, stg, KT, have_next, ga, gb, ga1, gb1, K, wave, wm, wn, fr, fq, rsw, swapped, acc);
#pragma unroll
        for (int i = 0; i < 4; ++i)
#pragma unroll
            for (int j = 0; j < 4; ++j) epi.store(m0 + wm * 64 + i * 16, n0 + wn * 64 + j * 16, acc[i][j], fr, fq);
        m0 = m1; n0 = n1; have = have_next;
    }
    __builtin_amdgcn_s_setprio(0);
    WAIT_VM0();
    __syncthreads();
}


constexpr int H_ABYTES = 256 * 64, H_STAGEB = 2 * H_ABYTES;
DI void gemmh_issue(const bf16_t* ga, const bf16_t* gb, int K, unsigned char* __restrict__ dst, int wave) {
#pragma unroll
    for (int i = 0; i < 2; ++i) {
        __builtin_amdgcn_global_load_lds((const unsigned*)(ga + (size_t)i * 128 * K), (unsigned*)(dst + (i * 8 + wave) * 1024), 16, 0, 0);
        __builtin_amdgcn_global_load_lds((const unsigned*)(gb + (size_t)i * 128 * K), (unsigned*)(dst + H_ABYTES + (i * 8 + wave) * 1024), 16, 0, 0);
    }
}
DI void gemmh_data(const unsigned char* __restrict__ sA, unsigned char* __restrict__ dNext, bool issue, const bf16_t* ga2, const bf16_t* gb2, int K, int wave,
                   int wm, int wn, int fr, int rpos, bf16x8 (&af)[8], bf16x8 (&bfr)[4]) {
    const unsigned char* sB = sA + H_ABYTES;
#pragma unroll
    for (int i = 0; i < 8; ++i) af[i] = *(const bf16x8*)(sA + (wm * 128 + i * 16 + fr) * 64 + rpos);
#pragma unroll
    for (int j = 0; j < 4; ++j) bfr[j] = *(const bf16x8*)(sB + (wn * 64 + j * 16 + fr) * 64 + rpos);
    __builtin_amdgcn_sched_barrier(0);
    if (issue) gemmh_issue(ga2, gb2, K, dNext, wave);
}
template <bool SW>
DI void gemmh_mfma(const bf16x8 (&af)[8], const bf16x8 (&bfr)[4], f32x4 (&acc)[8][4]) {
    if (!SW) {
#pragma unroll
        for (int i = 0; i < 8; ++i)
#pragma unroll
            for (int j = 0; j < 4; ++j) acc[i][j] = __builtin_amdgcn_mfma_f32_16x16x32_bf16(bfr[j], af[i], acc[i][j], 0, 0, 0);
    } else {
#pragma unroll
        for (int i = 0; i < 8; ++i)
#pragma unroll
            for (int j = 0; j < 4; ++j) acc[i][j] = __builtin_amdgcn_mfma_f32_16x16x32_bf16(af[i], bfr[j], acc[i][j], 0, 0, 0);
    }
}
template <int HALF, bool SW>
DI void gemmh_kloop(unsigned char* lds, int& stg, int KT, bool have_next, const bf16_t* ga, const bf16_t* gb, const bf16_t* ga1, const bf16_t* gb1, int K, int wave,
                    int wm, int wn, int fr, int rpos, f32x4 (&acc)[8][4]) {
    for (int kt = 0; kt < KT; ++kt) {
        bf16x8 af[8], bfr[4];
        const int s3 = stg >= 1 ? stg - 1 : 2;
        const bool in_tile = kt + 2 < KT, issue = in_tile || have_next;
        const bf16_t* pa = in_tile ? ga + (kt + 2) * 32 : ga1 + (kt + 2 - KT) * 32;
        const bf16_t* pb = in_tile ? gb + (kt + 2) * 32 : gb1 + (kt + 2 - KT) * 32;
        if (HALF == 0) {
            gemmh_data(lds + stg * H_STAGEB, lds + s3 * H_STAGEB, issue, pa, pb, K, wave, wm, wn, fr, rpos, af, bfr);
            asm volatile("s_waitcnt lgkmcnt(0)" ::: "memory");
            __builtin_amdgcn_s_barrier();
            gemmh_mfma<SW>(af, bfr, acc);
            if (issue) asm volatile("s_waitcnt vmcnt(4)" ::: "memory"); else asm volatile("s_waitcnt vmcnt(0)" ::: "memory");
            __builtin_amdgcn_s_barrier();
        } else {
            __builtin_amdgcn_s_barrier();
            gemmh_data(lds + stg * H_STAGEB, lds + s3 * H_STAGEB, issue, pa, pb, K, wave, wm, wn, fr, rpos, af, bfr);
            if (issue) asm volatile("s_waitcnt vmcnt(4)" ::: "memory"); else asm volatile("s_waitcnt vmcnt(0)" ::: "memory");
            asm volatile("s_waitcnt lgkmcnt(0)" ::: "memory");
            __builtin_amdgcn_s_barrier();
            gemmh_mfma<SW>(af, bfr, acc);
        }
        stg = stg == 2 ? 0 : stg + 1;
    }
}
template <class Epi>
DI bool gemmh_next_tile(TileCur& c, int& m0, int& n0, const Epi& epi, int SNn, int nsuper, int lb, int nl) {
    for (;;) {
        if (c.st >= nsuper) return false;
        const int sm = c.st / SNn, sn = c.st % SNn;
        m0 = (sm * 4 + (c.tt & 3)) * 256; n0 = (sn * 8 + (c.tt >> 2)) * 256;
        c.tt += nl;
        if (c.tt >= 32) { c.tt = lb; c.st += 8; }
        if (!epi.skip(m0, n0)) return true;
    }
}
template <class Epi>
__device__ void gemmh_phase(const bf16_t* __restrict__ A, const bf16_t* __restrict__ Bt, int M, int N, int K, const Epi& epi, unsigned char* lds) {
    const int tid = opaque_tid(), lane = tid & 63, wave = __builtin_amdgcn_readfirstlane(tid >> 6), wm = wave >> 2, wn = wave & 3;
    const int fr = lane & 15, fq = lane >> 4;
    const int MT = M / 256, NT = N / 256, SMn = MT / 4, SNn = NT / 8, nsuper = SMn * SNn;
    const int xcd = blockIdx.x & 7, lb = blockIdx.x >> 3, nl = gridDim.x >> 3;
    const int KT = K / 32;
    const int rl = wave * 16 + (lane >> 2), lchunk = (lane & 3) ^ ((0 - (lane >> 4)) & 3);
    const int rpos = (fq ^ ((0 - (fr >> 2)) & 3)) << 4;
    TileCur cur{xcd, lb};
    int m0, n0, m1 = 0, n1 = 0;
    bool have = gemmh_next_tile(cur, m0, n0, epi, SNn, nsuper, lb, nl);
    WAIT_VM0();
    __syncthreads();
    int stg = 0;
    if (have) {
        const bf16_t* ga = A + (size_t)(m0 + rl) * K + lchunk * 8;
        const bf16_t* gb = Bt + (size_t)(n0 + rl) * K + lchunk * 8;
        gemmh_issue(ga, gb, K, lds, wave);
        gemmh_issue(ga + 32, gb + 32, K, lds + H_STAGEB, wave);
        asm volatile("s_waitcnt vmcnt(4)" ::: "memory");
    }
    __syncthreads();
    const int half = wave >> 2;
    if (half) __builtin_amdgcn_s_setprio(1);
    while (have) {
        const bool have_next = gemmh_next_tile(cur, m1, n1, epi, SNn, nsuper, lb, nl);
        const bool swapped = epi.swapped(n0);
        f32x4 acc[8][4];
#pragma unroll
        for (int i = 0; i < 8; ++i)
#pragma unroll
            for (int j = 0; j < 4; ++j) acc[i][j] = (f32x4){0.f, 0.f, 0.f, 0.f};
        const bf16_t* ga = A + (size_t)(m0 + rl) * K + lchunk * 8;
        const bf16_t* gb = Bt + (size_t)(n0 + rl) * K + lchunk * 8;
        const bf16_t* ga1 = A + (size_t)(m1 + rl) * K + lchunk * 8;
        const bf16_t* gb1 = Bt + (size_t)(n1 + rl) * K + lchunk * 8;
        if (!swapped) {
            if (half == 0) gemmh_kloop<0, false>(lds, stg, KT, have_next, ga, gb, ga1, gb1, K, wave, wm, wn, fr, rpos, acc);
            else gemmh_kloop<1, false>(lds, stg, KT, have_next, ga, gb, ga1, gb1, K, wave, wm, wn, fr, rpos, acc);
        } else {
            if (half == 0) gemmh_kloop<0, true>(lds, stg, KT, have_next, ga, gb, ga1, gb1, K, wave, wm, wn, fr, rpos, acc);
            else gemmh_kloop<1, true>(lds, stg, KT, have_next, ga, gb, ga1, gb1, K, wave, wm, wn, fr, rpos, acc);
        }
#pragma unroll
        for (int i = 0; i < 8; ++i)
#pragma unroll
            for (int j = 0; j < 4; j += 2) epi.store2(m0 + wm * 128 + i * 16, n0 + wn * 64 + j * 16, acc[i][j], acc[i][j + 1], fr, fq);
        m0 = m1; n0 = n1; have = have_next;
    }
    __builtin_amdgcn_s_setprio(0);
    WAIT_VM0();
    __syncthreads();
}

struct EpiPlanes {
    bf16_t* P; const float* LB;
    DI bool skip(int, int) const { return false; }
    DI bool swapped(int) const { return false; }
    DI uint2 act(int n, const f32x4& a) const {
        const int pl = n >> 11, c = n & 2047;
        float v0 = a[0], v1 = a[1], v2 = a[2], v3 = a[3];
        if (pl == 0 || pl == 4) { v0 = siluf_(v0); v1 = siluf_(v1); v2 = siluf_(v2); v3 = siluf_(v3); }
        else if (pl != 3) {
            const f32x4 lb = *(const f32x4*)(LB + (pl - 1) * 2048 + c);
            v0 = 0.6931471805599453f * __builtin_amdgcn_logf(lb[0] + (1.f - lb[0]) * sigmoidf_(v0)); v1 = 0.6931471805599453f * __builtin_amdgcn_logf(lb[1] + (1.f - lb[1]) * sigmoidf_(v1));
            v2 = 0.6931471805599453f * __builtin_amdgcn_logf(lb[2] + (1.f - lb[2]) * sigmoidf_(v2)); v3 = 0.6931471805599453f * __builtin_amdgcn_logf(lb[3] + (1.f - lb[3]) * sigmoidf_(v3));
        }
        uint2 o; o.x = pk2(v0, v1); o.y = pk2(v2, v3);
        return o;
    }
    DI void store(int mb, int nb, const f32x4& a, int fr, int fq) const {
        const int row = mb + fr, n = nb + fq * 4, pl = n >> 11, c = n & 2047;
        *(uint2*)(P + ((size_t)pl * GROWS + row) * DI_ + c) = act(n, a);
    }
    DI void store2(int mb, int nb, const f32x4& a, const f32x4& b, int fr, int fq) const {
        const uint2 oa = act(nb + fq * 4, a), ob = act(nb + 16 + fq * 4, b);
        const bool odd = fq & 1;
        typedef unsigned u2v __attribute__((ext_vector_type(2)));
        const u2v px = __builtin_amdgcn_permlane16_swap(oa.x, ob.x, false, false), py = __builtin_amdgcn_permlane16_swap(oa.y, ob.y, false, false);
        uint4 o; o.x = px.x; o.y = py.x; o.z = px.y; o.w = py.y;
        const int row = mb + fr, n = nb + (odd ? 16 : 0) + (fq & ~1) * 4, pl = n >> 11, c = n & 2047;
        *(uint4*)(P + ((size_t)pl * GROWS + row) * DI_ + c) = o;
    }
};
struct EpiOut0 {
    const float *x, *ctx, *MOD0; float *out, *x1ctx; int g;
    DI bool skip(int, int) const { return false; }
    DI bool swapped(int) const { return false; }
    DI void store(int mb, int nb, const f32x4& a, int fr, int fq) const {
        const int row = mb + fr, n = nb + fq * 4;
        const int b = g * GB_ + row / TPB, t = row % TPB;
        const bool isctx = t < CTX;
        const f32x4 gt = *(const f32x4*)(MOD0 + (size_t)(isctx ? 8 : b) * 3072 + 2048 + n);
        const size_t idx = isctx ? ((size_t)b * CTX + t) * D + n : ((size_t)b * SEQ + (t - CTX)) * D + n;
        const f32x4 xi = *(const f32x4*)((isctx ? ctx : x) + idx);
        *(f32x4*)((isctx ? x1ctx : out) + idx) = xi + gt * a;
    }
};
struct EpiOut1 {
    const float* MOD1; float* out; int g;
    DI bool skip(int, int) const { return false; }
    DI bool swapped(int) const { return false; }
    DI void store(int mb, int nb, const f32x4& a, int fr, int fq) const {
        const int row = mb + fr, n = nb + fq * 4;
        const int b = g * GB_ + row / SEQ;
        const f32x4 gt = *(const f32x4*)(MOD1 + (size_t)b * 3072 + 2048 + n);
        float* o = out + ((size_t)g * GLAT + row) * D + n;
        *(f32x4*)o = *(const f32x4*)o + gt * a;
    }
};
struct EpiDA {
    bf16_t *Q, *Kb, *Vt, *G;
    DI bool skip(int m0, int n0) const { const int sec = n0 >> 11; return (sec == 0 || sec == 3) && (m0 % TPB) < CTX; }
    DI bool swapped(int n0) const { return (n0 >> 11) == 2; }
    DI uint2 val(int sec, int t, int c, const f32x4& a) const {
        float v0 = a[0], v1 = a[1], v2 = a[2], v3 = a[3];
        if (sec <= 1 && t >= CTX) {
            const int l = t - CTX, ep = c & 127, ax = (ep >> 5) & 1, i0 = (ep & 31) >> 1;
            const float pos = (float)(ax ? (l & 63) : (l >> 6));
            const float a0 = pos * __builtin_amdgcn_exp2f(-0.83048202372184f * (float)i0), a1 = pos * __builtin_amdgcn_exp2f(-0.83048202372184f * (float)(i0 + 1));
            const float c0 = __cosf(a0), s0 = __sinf(a0), c1 = __cosf(a1), s1 = __sinf(a1);
            const float r0 = v0 * c0 - v1 * s0, r1 = v1 * c0 + v0 * s0, r2 = v2 * c1 - v3 * s1, r3 = v3 * c1 + v2 * s1;
            v0 = r0; v1 = r1; v2 = r2; v3 = r3;
        }
        if (sec == 0) { v0 *= QSCALE; v1 *= QSCALE; v2 *= QSCALE; v3 *= QSCALE; }
        uint2 o; o.x = pk2(v0, v1); o.y = pk2(v2, v3);
        return o;
    }
    DI bf16_t* dst(int sec, int row, int bl, int t, int c) const {
        if (sec == 1) return Kb + (size_t)row * DI_ + c;
        return (sec == 0 ? Q : G) + ((size_t)bl * SEQ + (t - CTX)) * DI_ + c;
    }
    DI void store(int mb, int nb, const f32x4& a, int fr, int fq) const {
        const int sec = nb >> 11;
        if (sec == 2) {
            const int row = mb + fq * 4, bl = row / TPB, t = row % TPB, c = (nb & 2047) + fr, hd = c >> 7, e = c & 127;
            uint2 o; o.x = pk2(a[0], a[1]); o.y = pk2(a[2], a[3]);
            *(uint2*)(Vt + ((size_t)(bl * NH + hd) * 128 + e) * TPB + t) = o;
            return;
        }
        const int row = mb + fr, bl = row / TPB, t = row % TPB, c = (nb & 2047) + fq * 4;
        *(uint2*)dst(sec, row, bl, t, c) = val(sec, t, c, a);
    }
    DI void store2(int mb, int nb, const f32x4& a, const f32x4& b, int fr, int fq) const {
        const int sec = nb >> 11;
        const bool odd = fq & 1;
        uint2 oa, ob;
        if (sec == 2) { oa.x = pk2(a[0], a[1]); oa.y = pk2(a[2], a[3]); ob.x = pk2(b[0], b[1]); ob.y = pk2(b[2], b[3]); }
        else {
            const int t = (mb + fr) % TPB, c = (nb & 2047) + fq * 4;
            oa = val(sec, t, c, a); ob = val(sec, t, c + 16, b);
        }
        typedef unsigned u2v __attribute__((ext_vector_type(2)));
        const u2v px = __builtin_amdgcn_permlane16_swap(oa.x, ob.x, false, false), py = __builtin_amdgcn_permlane16_swap(oa.y, ob.y, false, false);
        uint4 o; o.x = px.x; o.y = py.x; o.z = px.y; o.w = py.y;
        if (sec == 2) {
            const int row = mb + (fq & ~1) * 4, bl = row / TPB, t = row % TPB, c = (nb & 2047) + (odd ? 16 : 0) + fr, hd = c >> 7, e = c & 127;
            *(uint4*)(Vt + ((size_t)(bl * NH + hd) * 128 + e) * TPB + t) = o;
            return;
        }
        const int row = mb + fr, bl = row / TPB, t = row % TPB, c = (nb & 2047) + (odd ? 16 : 0) + (fq & ~1) * 4;
        *(uint4*)dst(sec, row, bl, t, c) = o;
    }
};

constexpr int SC_RAWQ = 0, SC_RAWZ = 8320, SC_RAWV = 16640, SC_RAWSTG = 20992;
constexpr int SC_QE = 2 * SC_RAWSTG, SC_KE = SC_QE + 8192, SC_KDT = SC_KE + 8192, SC_VT = SC_KDT + 8192, SC_ER = SC_VT + 4096, SC_EB = SC_ER + 512, SC_YI = SC_EB + 512;
DI int scan_tok(int n, int dir) { return dir == 0 ? n : (n < CTX ? CTX - 1 - n : (TPB + CTX - 1) - n); }
__device__ void phase_scan(const Params& p, unsigned char* lds) {
    const int tid = opaque_tid(), lane = tid & 63, wave = __builtin_amdgcn_readfirstlane(tid >> 6), r = lane & 31, h = lane >> 5;
    const int c = tid >> 2, tq = tid & 3;
    const int pc = (c & ~12) | ((c & 4) << 1) | ((c & 8) >> 1);
    const bf16_t* P1 = (const bf16_t*)(p.ws + OFF_P1);
    for (int u = blockIdx.x; u < 256; u += gridDim.x) {
        const int vh = (u >> 3) & 1, sidx = (u >> 4) * 8 + (u & 7), dir = sidx & 1, hd = (sidx >> 1) & 15, bl = sidx >> 5;
        bf16_t* Od = (bf16_t*)(p.ws + (dir ? OFF_OB : OFF_OF));
        const bf16_t* gq = P1 + hd * 128 + (lane & 15) * 8;
        const bf16_t* gz = P1 + (size_t)(1 + dir) * GROWS * DI_ + hd * 128 + (lane & 15) * 8;
        const bf16_t* gvv = P1 + (size_t)3 * GROWS * DI_ + hd * 128 + vh * 64 + (lane & 7) * 8;
        f32x16 S[4];
#pragma unroll
        for (int i = 0; i < 4; ++i)
#pragma unroll
            for (int j = 0; j < 16; ++j) S[i][j] = 0.f;
        WAIT_VM0();
        {
            const size_t rq = (size_t)bl * TPB + scan_tok(4 * wave + (lane >> 4), dir);
            __builtin_amdgcn_global_load_lds((const unsigned*)(gq + rq * DI_), (unsigned*)(lds + SC_RAWQ + wave * 1040), 16, 0, 0);
            __builtin_amdgcn_global_load_lds((const unsigned*)(gz + rq * DI_), (unsigned*)(lds + SC_RAWZ + wave * 1040), 16, 0, 0);
            if (wave < 4) {
                const size_t rv = (size_t)bl * TPB + scan_tok(8 * wave + (lane >> 3), dir);
                __builtin_amdgcn_global_load_lds((const unsigned*)(gvv + rv * DI_), (unsigned*)(lds + SC_RAWV + wave * 1056), 16, 0, 0);
            }
        }
        WAIT_VM0();
        __syncthreads();
        constexpr int NCH = TPB / 32;
        f32x16 Ykeep;
#pragma unroll
        for (int j = 0; j < 16; ++j) Ykeep[j] = 0.f;
        for (int n = 0; n < NCH; ++n) {
            const unsigned char* raw = lds + (n & 1) * SC_RAWSTG;
            if (n + 1 < NCH) {
                unsigned char* nxt = lds + ((n + 1) & 1) * SC_RAWSTG;
                const size_t rq = (size_t)bl * TPB + scan_tok((n + 1) * 32 + 4 * wave + (lane >> 4), dir);
                __builtin_amdgcn_global_load_lds((const unsigned*)(gq + rq * DI_), (unsigned*)(nxt + SC_RAWQ + wave * 1040), 16, 0, 0);
                __builtin_amdgcn_global_load_lds((const unsigned*)(gz + rq * DI_), (unsigned*)(nxt + SC_RAWZ + wave * 1040), 16, 0, 0);
                if (wave < 4) {
                    const size_t rv = (size_t)bl * TPB + scan_tok((n + 1) * 32 + 8 * wave + (lane >> 3), dir);
                    __builtin_amdgcn_global_load_lds((const unsigned*)(gvv + rv * DI_), (unsigned*)(nxt + SC_RAWV + wave * 1056), 16, 0, 0);
                }
            }
            if (wave < 2 && n > 0) {
                const size_t orow = (size_t)bl * TPB + scan_tok((n - 1) * 32 + r, dir);
                bf16_t* op = Od + orow * DI_ + hd * 128 + vh * 64 + wave * 32 + 4 * h;
#pragma unroll
                for (int g4 = 0; g4 < 4; ++g4) {
                    const float* yi = (const float*)(lds + SC_YI) + (wave * 16 + 4 * g4) * 64 + lane;
                    uint2 o; o.x = pk2(Ykeep[4 * g4] + yi[0], Ykeep[4 * g4 + 1] + yi[64]); o.y = pk2(Ykeep[4 * g4 + 2] + yi[128], Ykeep[4 * g4 + 3] + yi[192]);
                    *(uint2*)(op + 8 * g4) = o; }
            }
            {
                float b[8], kk[8], qs[8];
                float run = 0.f;
#pragma unroll
                for (int i = 0; i < 8; ++i) {
                    const int t = tq * 8 + i, off = (t >> 2) * 1040 + (t & 3) * 256 + c * 2;
                    const float g = __uint_as_float((unsigned)(*(const bf16_t*)(raw + SC_RAWZ + off)) << 16);
                    const float qv = __uint_as_float((unsigned)(*(const bf16_t*)(raw + SC_RAWQ + off)) << 16);
                    run += g; b[i] = run; kk[i] = 1.f - __expf(g); qs[i] = qv;
                }
                float x = run, y = qperm<0x90>(x);
                if (tq >= 1) x += y;
                y = qperm<0x44>(x);
                if (tq >= 2) x += y;
                const float excl = x - run;
                const float Btot = qperm<0xFF>(x);
                const float b7 = b[7] + excl;
                const float rho = qperm<0x55>(b7);
                const float eBr = __expf(Btot - rho);
                unsigned kd[4];
                float kdprev = 0.f;
#pragma unroll
                for (int i = 0; i < 8; ++i) {
                    const int t = tq * 8 + i;
                    const float d = b[i] + excl - rho;
                    const float ea = __expf(d), eb = __builtin_amdgcn_rcpf(ea);
                    const float qe = qs[i] * ea, ke = kk[i] * eb, kdv = ke * eBr;
                    const int addr = t * 256 + (((pc >> 3) ^ (t & 15)) << 4) + (pc & 7) * 2;
                    *(bf16_t*)(lds + SC_QE + addr) = (bf16_t)(pk2(qe, 0.f) & 0xffffu);
                    *(bf16_t*)(lds + SC_KE + addr) = (bf16_t)(pk2(ke, 0.f) & 0xffffu);
                    if (i & 1) kd[i >> 1] = pk2(kdprev, kdv); else kdprev = kdv;
                }
                uint4 kdw; kdw.x = kd[0]; kdw.y = kd[1]; kdw.z = kd[2]; kdw.w = kd[3];
                *(uint4*)(lds + SC_KDT + c * 64 + ((tq ^ ((c >> 2) & 3)) << 4)) = kdw;
                if (tq == 0) { *(float*)(lds + SC_ER + c * 4) = __expf(rho); *(float*)(lds + SC_EB + c * 4) = __expf(Btot); }
                if (tid < 256) {
                    const int dv = c;
                    unsigned short vv[8];
#pragma unroll
                    for (int i = 0; i < 8; ++i) vv[i] = *(const bf16_t*)(raw + SC_RAWV + tq * 1056 + i * 128 + dv * 2);
                    uint4 w; w.x = vv[0] | ((unsigned)vv[1] << 16); w.y = vv[2] | ((unsigned)vv[3] << 16); w.z = vv[4] | ((unsigned)vv[5] << 16); w.w = vv[6] | ((unsigned)vv[7] << 16);
                    *(uint4*)(lds + SC_VT + dv * 64 + ((tq ^ ((dv >> 2) & 3)) << 4)) = w;
                }
            }
            __syncthreads();
            if (wave < 2) {
                const int dvb = wave, sw4 = (r >> 2) & 3;
                const unsigned char* qrow = lds + SC_QE + r * 256;
                const unsigned char* vrow = lds + SC_VT + (dvb * 32 + r) * 64;
                bf16x8 qf[8];
#pragma unroll
                for (int k8 = 0; k8 < 8; ++k8) qf[k8] = *(const bf16x8*)(qrow + (((2 * k8 + h) ^ (r & 15)) << 4));
                f32x16 Y, Y2;
#pragma unroll
                for (int j = 0; j < 16; ++j) { Y[j] = 0.f; Y2[j] = 0.f; }
#pragma unroll
                for (int dkb = 0; dkb < 4; ++dkb) {
                    f32x4 er[4];
#pragma unroll
                    for (int g4 = 0; g4 < 4; ++g4) er[g4] = *(const f32x4*)(lds + SC_ER + (dkb * 32 + 8 * g4 + 4 * h) * 4);
                    unsigned pkd[8];
#pragma unroll
                    for (int g4 = 0; g4 < 4; ++g4) {
                        pkd[2 * g4] = pk2(S[dkb][4 * g4] * er[g4][0], S[dkb][4 * g4 + 1] * er[g4][1]);
                        pkd[2 * g4 + 1] = pk2(S[dkb][4 * g4 + 2] * er[g4][2], S[dkb][4 * g4 + 3] * er[g4][3]);
                    }
                    typedef unsigned u4 __attribute__((ext_vector_type(4)));
                    const u4 t0 = {pkd[0], pkd[1], pkd[2], pkd[3]}, t1 = {pkd[4], pkd[5], pkd[6], pkd[7]};
                    Y = __builtin_amdgcn_mfma_f32_32x32x16_bf16(__builtin_bit_cast(bf16x8, t0), qf[dkb * 2], Y, 0, 0, 0);
                    Y2 = __builtin_amdgcn_mfma_f32_32x32x16_bf16(__builtin_bit_cast(bf16x8, t1), qf[dkb * 2 + 1], Y2, 0, 0, 0);
                }
#pragma unroll
                for (int j = 0; j < 16; ++j) Ykeep[j] = Y[j] + Y2[j];
                bf16x8 kdf[8], vf2[2];
#pragma unroll
                for (int dkb = 0; dkb < 4; ++dkb)
#pragma unroll
                    for (int s2 = 0; s2 < 2; ++s2) kdf[dkb * 2 + s2] = *(const bf16x8*)(lds + SC_KDT + (dkb * 32 + r) * 64 + (((2 * s2 + h) ^ sw4) << 4));
#pragma unroll
                for (int s2 = 0; s2 < 2; ++s2) vf2[s2] = *(const bf16x8*)(vrow + (((2 * s2 + h) ^ sw4) << 4));
#pragma unroll
                for (int dkb = 0; dkb < 4; ++dkb) {
                    f32x4 eb[4];
#pragma unroll
                    for (int g4 = 0; g4 < 4; ++g4) eb[g4] = *(const f32x4*)(lds + SC_EB + (dkb * 32 + 8 * g4 + 4 * h) * 4);
#pragma unroll
                    for (int g4 = 0; g4 < 4; ++g4) { S[dkb][4 * g4] *= eb[g4][0]; S[dkb][4 * g4 + 1] *= eb[g4][1]; S[dkb][4 * g4 + 2] *= eb[g4][2]; S[dkb][4 * g4 + 3] *= eb[g4][3]; }
#pragma unroll
                    for (int s2 = 0; s2 < 2; ++s2) S[dkb] = __builtin_amdgcn_mfma_f32_32x32x16_bf16(kdf[dkb * 2 + s2], vf2[s2], S[dkb], 0, 0, 0);
                }
            } else if (wave < 4) {
                const int dvb = wave - 2, sw4 = (r >> 2) & 3;
                const unsigned char* qrow = lds + SC_QE + r * 256;
                const unsigned char* krow_ = lds + SC_KE + r * 256;
                const unsigned char* vrow = lds + SC_VT + (dvb * 32 + r) * 64;
                bf16x8 qf[8], kf[8];
#pragma unroll
                for (int k8 = 0; k8 < 8; ++k8) { const int ch = ((2 * k8 + h) ^ (r & 15)) << 4; kf[k8] = *(const bf16x8*)(krow_ + ch); qf[k8] = *(const bf16x8*)(qrow + ch); }
                uint2 vlo[2], vhi[2];
#pragma unroll
                for (int s2 = 0; s2 < 2; ++s2) { vlo[s2] = *(const uint2*)(vrow + (((2 * s2) ^ sw4) << 4) + 8 * h); vhi[s2] = *(const uint2*)(vrow + (((2 * s2 + 1) ^ sw4) << 4) + 8 * h); }
                f32x16 PT, PT2, Yi;
#pragma unroll
                for (int j = 0; j < 16; ++j) { PT[j] = 0.f; PT2[j] = 0.f; Yi[j] = 0.f; }
#pragma unroll
                for (int k8 = 0; k8 < 8; k8 += 2) {
                    PT = __builtin_amdgcn_mfma_f32_32x32x16_bf16(kf[k8], qf[k8], PT, 0, 0, 0);
                    PT2 = __builtin_amdgcn_mfma_f32_32x32x16_bf16(kf[k8 + 1], qf[k8 + 1], PT2, 0, 0, 0);
                }
                unsigned pp[8];
#pragma unroll
                for (int j = 0; j < 8; ++j) {
                    const int i0 = 2 * j, i1 = 2 * j + 1;
                    const int j0 = (i0 & 3) + 8 * (i0 >> 2) + 4 * h, j1 = (i1 & 3) + 8 * (i1 >> 2) + 4 * h;
                    pp[j] = pk2(j0 <= r ? PT[i0] + PT2[i0] : 0.f, j1 <= r ? PT[i1] + PT2[i1] : 0.f);
                }
#pragma unroll
                for (int s2 = 0; s2 < 2; ++s2) {
                    typedef unsigned u4 __attribute__((ext_vector_type(4)));
                    const u4 t0 = {pp[4 * s2], pp[4 * s2 + 1], pp[4 * s2 + 2], pp[4 * s2 + 3]};
                    const u4 t1 = {vlo[s2].x, vlo[s2].y, vhi[s2].x, vhi[s2].y};
                    Yi = __builtin_amdgcn_mfma_f32_32x32x16_bf16(__builtin_bit_cast(bf16x8, t1), __builtin_bit_cast(bf16x8, t0), Yi, 0, 0, 0);
                }
                float* yo = (float*)(lds + SC_YI) + (dvb * 16) * 64 + lane;
#pragma unroll
                for (int j = 0; j < 16; ++j) yo[j * 64] = Yi[j];
            }
            WAIT_VM0();
            __syncthreads();
        }
        if (wave < 2) {
            const size_t orow = (size_t)bl * TPB + scan_tok((NCH - 1) * 32 + r, dir);
            bf16_t* op = Od + orow * DI_ + hd * 128 + vh * 64 + wave * 32 + 4 * h;
#pragma unroll
            for (int g4 = 0; g4 < 4; ++g4) {
                    const float* yi = (const float*)(lds + SC_YI) + (wave * 16 + 4 * g4) * 64 + lane;
                    uint2 o; o.x = pk2(Ykeep[4 * g4] + yi[0], Ykeep[4 * g4 + 1] + yi[64]); o.y = pk2(Ykeep[4 * g4 + 2] + yi[128], Ykeep[4 * g4 + 3] + yi[192]);
                    *(uint2*)(op + 8 * g4) = o; }
        }
    }
}

__device__ void phase_combine(const Params& p) {
    const bf16_t* OF = (const bf16_t*)(p.ws + OFF_OF);
    const bf16_t* OB = (const bf16_t*)(p.ws + OFF_OB);
    bf16_t* GP = (bf16_t*)(p.ws + OFF_P1 + 4 * PLANE);
    const size_t total = (size_t)GROWS * DI_ / 8;
    const int tid_c = opaque_tid();
    for (size_t it = (size_t)blockIdx.x * NTH + tid_c; it < total; it += (size_t)gridDim.x * NTH) {
        const size_t e0 = it * 8;
        const int c = (int)(e0 & 2047);
        const uint4 a = nt_loadu4(OF + e0), b = nt_loadu4(OB + e0), gt = nt_loadu4(GP + e0);
        const unsigned as[4] = {a.x, a.y, a.z, a.w}, bs[4] = {b.x, b.y, b.z, b.w}, gs[4] = {gt.x, gt.y, gt.z, gt.w};
        float o[8], ss = 0.f;
#pragma unroll
        for (int j = 0; j < 4; ++j) { o[2 * j] = bf_lo(as[j]) + bf_lo(bs[j]); o[2 * j + 1] = bf_hi(as[j]) + bf_hi(bs[j]); ss += o[2 * j] * o[2 * j] + o[2 * j + 1] * o[2 * j + 1]; }
        ss += __shfl_xor(ss, 1); ss += __shfl_xor(ss, 2); ss += __shfl_xor(ss, 4); ss += __shfl_xor(ss, 8);
        const float rstd = rsqrtf(ss * (1.0f / 128.f) + EPS);
        float y[8];
#pragma unroll
        for (int j = 0; j < 4; ++j) {
            y[2 * j] = o[2 * j] * rstd * p.hg_norm_g[c + 2 * j] * bf_lo(gs[j]);
            y[2 * j + 1] = o[2 * j + 1] * rstd * p.hg_norm_g[c + 2 * j + 1] * bf_hi(gs[j]);
        }
        uint4 r; r.x = pk2(y[0], y[1]); r.y = pk2(y[2], y[3]); r.z = pk2(y[4], y[5]); r.w = pk2(y[6], y[7]);
        *(uint4*)((bf16_t*)(p.ws + OFF_OF) + e0) = r;
    }
}

constexpr int AT_STAGE = 32768;
DI float rowmax16(const f32x16& s) {
    float m = fmaxf(fmaxf(s[0], s[1]), fmaxf(s[2], s[3]));
    m = fmaxf(m, fmaxf(fmaxf(s[4], s[5]), fmaxf(s[6], s[7])));
    m = fmaxf(m, fmaxf(fmaxf(s[8], s[9]), fmaxf(s[10], s[11])));
    m = fmaxf(m, fmaxf(fmaxf(s[12], s[13]), fmaxf(s[14], s[15])));
    return m;
}
DI void attn_issue(const bf16_t* gk, const bf16_t* gv, unsigned char* __restrict__ dst, int wave) {
#pragma unroll
    for (int i = 0; i < 2; ++i) {
        __builtin_amdgcn_global_load_lds((const unsigned*)(gk + (size_t)(i * 32) * DI_), (unsigned*)(dst + (i * 8 + wave) * 1024), 16, 0, 0);
        __builtin_amdgcn_global_load_lds((const unsigned*)(gv + (size_t)i * 64 * TPB), (unsigned*)(dst + 16384 + (i * 8 + wave) * 1024), 16, 0, 0);
    }
}
DI void attn_issue_half(const bf16_t* gk, const bf16_t* gv, unsigned char* __restrict__ dst, int wave, int i) {
    __builtin_amdgcn_global_load_lds((const unsigned*)(gk + (size_t)(i * 32) * DI_), (unsigned*)(dst + (i * 8 + wave) * 1024), 16, 0, 0);
    __builtin_amdgcn_global_load_lds((const unsigned*)(gv + (size_t)i * 64 * TPB), (unsigned*)(dst + 16384 + (i * 8 + wave) * 1024), 16, 0, 0);
}
DI void attn_read_k(const unsigned char* kp, int ph, int h, int ksw, bf16x8 (&kf)[4]) {
#pragma unroll
    for (int ks = 0; ks < 4; ++ks) kf[ks] = *(const bf16x8*)(kp + ((8 * ph + 2 * ks + h) ^ ksw) * 16);
}
DI void attn_read_v(const unsigned char* vp, int kb, int h, int vsw, bf16x8 (&vf)[8]) {
#pragma unroll
    for (int s2 = 0; s2 < 2; ++s2)
#pragma unroll
        for (int vb = 0; vb < 4; ++vb) vf[s2 * 4 + vb] = *(const bf16x8*)(vp + vb * 4096 + ((kb * 4 + 2 * s2 + h) ^ vsw) * 16);
}
DI f32x16 attn_qk(const bf16x8 (&kf)[4], const bf16x8 (&Qf)[4], const f32x16& NM) {
    f32x16 S = __builtin_amdgcn_mfma_f32_32x32x16_bf16(kf[0], Qf[0], NM, 0, 0, 0);
#pragma unroll
    for (int ks = 1; ks < 4; ++ks) S = __builtin_amdgcn_mfma_f32_32x32x16_bf16(kf[ks], Qf[ks], S, 0, 0, 0);
    return S;
}
DI void attn_softmax(f32x16& S, float mm_used, bool first, f32x16 (&O)[4], f32x16& NM, float& mm, float& ls, unsigned (&P)[8]) {
    float e[16];
#pragma unroll
    for (int j = 0; j < 16; ++j) e[j] = __builtin_amdgcn_exp2f(S[j]);
    float ps = ((e[0] + e[1]) + (e[2] + e[3])) + ((e[4] + e[5]) + (e[6] + e[7])) + (((e[8] + e[9]) + (e[10] + e[11])) + ((e[12] + e[13]) + (e[14] + e[15])));
    const float adj = mm_used - mm;
    if (first || __any(!(ps <= 4096.f) || adj != 0.f)) {
        float rm = rowmax16(S) + adj;
        rm = fmaxf(rm, __shfl_xor(rm, 32));
        const float dlt = first ? rm : fmaxf(rm, 0.f);
        const float al = first ? 1.0f : __builtin_amdgcn_exp2f(-dlt);
        mm += dlt; ls *= al;
        const float sub = dlt - adj, nm = -mm;
#pragma unroll
        for (int j = 0; j < 16; ++j) { e[j] = __builtin_amdgcn_exp2f(S[j] - sub); NM[j] = nm; }
        ps = ((e[0] + e[1]) + (e[2] + e[3])) + ((e[4] + e[5]) + (e[6] + e[7])) + (((e[8] + e[9]) + (e[10] + e[11])) + ((e[12] + e[13]) + (e[14] + e[15])));
#pragma unroll
        for (int i = 0; i < 4; ++i)
#pragma unroll
            for (int j = 0; j < 16; ++j) O[i][j] *= al;
    }
    ls += ps;
#pragma unroll
    for (int j = 0; j < 8; ++j) P[j] = pk2(e[2 * j], e[2 * j + 1]);
}
DI void attn_pv(const unsigned (&P)[8], const bf16x8 (&vf)[8], f32x16 (&O)[4]) {
#pragma unroll
    for (int s2 = 0; s2 < 2; ++s2) {
        typedef unsigned u4 __attribute__((ext_vector_type(4)));
        const u4 t0 = {P[4 * s2], P[4 * s2 + 1], P[4 * s2 + 2], P[4 * s2 + 3]};
        const bf16x8 pf = __builtin_bit_cast(bf16x8, t0);
#pragma unroll
        for (int vb = 0; vb < 4; ++vb) O[vb] = __builtin_amdgcn_mfma_f32_32x32x16_bf16(vf[s2 * 4 + vb], pf, O[vb], 0, 0, 0);
    }
}
DI void attn_tile(const unsigned char* __restrict__ sCur, const unsigned char* __restrict__ sNxt, unsigned char* __restrict__ dIss, bool has_next, bool last_wait0, bool issue,
                  const bf16_t* gk3, const bf16_t* gv3, int wave, bool first_tile, int pr, int ph, int h, int r, int ksw, int vsw,
                  const bf16x8 (&Qf)[4], f32x16 (&O)[4], f32x16& Snext, f32x16& NM, float& mm_n, float& mm, float& ls) {
    const unsigned char* vp = sCur + 16384 + r * 128;
    bf16x8 kf[4], vf[8];
    unsigned P[8];
    attn_read_k(sCur + (32 + pr) * 256, ph, h, ksw, kf);
    attn_read_v(vp, 0, h, vsw, vf);
    __builtin_amdgcn_sched_barrier(0);
    if (issue) attn_issue_half(gk3, gv3, dIss, wave, 0);
    f32x16 Sc = Snext; float mmc = mm_n;
    Snext = attn_qk(kf, Qf, NM); mm_n = mm;
    attn_softmax(Sc, mmc, first_tile, O, NM, mm, ls, P);
    attn_pv(P, vf, O);
    Sc = Snext; mmc = mm_n;
    attn_read_v(vp, 1, h, vsw, vf);
    attn_softmax(Sc, mmc, false, O, NM, mm, ls, P);
    attn_pv(P, vf, O);
    if (has_next) {
        if (issue) asm volatile("s_waitcnt vmcnt(6)" ::: "memory"); else if (!last_wait0) asm volatile("s_waitcnt vmcnt(4)" ::: "memory"); else asm volatile("s_waitcnt vmcnt(0)" ::: "memory");
        asm volatile("s_waitcnt lgkmcnt(0)" ::: "memory");
        __builtin_amdgcn_s_barrier();
        attn_read_k(sNxt + pr * 256, ph, h, ksw, kf);
        __builtin_amdgcn_sched_barrier(0);
        if (issue) attn_issue_half(gk3, gv3, dIss, wave, 1);
        Snext = attn_qk(kf, Qf, NM); mm_n = mm;
    }
}
__device__ void phase_attn(const Params& p, unsigned char* lds) {
    const int tid = opaque_tid(), lane = tid & 63, wave = __builtin_amdgcn_readfirstlane(tid >> 6), r = lane & 31, h = lane >> 5;
    const int qg = wave >> 1, ph = wave & 1;
    if (wave >= 4) __builtin_amdgcn_s_setprio(1);
    const bf16_t* Qb = (const bf16_t*)(p.ws + OFF_QB);
    const bf16_t* Kb = (const bf16_t*)(p.ws + OFF_KB);
    const bf16_t* Vt = (const bf16_t*)(p.ws + OFF_VT);
    const bf16_t* Gb = (const bf16_t*)(p.ws + OFF_GB);
    bf16_t* Y = (bf16_t*)(p.ws + OFF_Y2);
    const float lam = ((const float*)(p.ws + OFF_SCAL))[0];
    const int xcd = blockIdx.x & 7, lb = blockIdx.x >> 3, nl = gridDim.x >> 3;
    const int pr = (r & ~12) | ((r & 4) << 1) | ((r & 8) >> 1);
    const int kr0 = wave * 4 + (lane >> 4), kchunk = (lane & 15) ^ (kr0 & 15);
    const int vr0 = wave * 8 + (lane >> 3), vchunk = (lane & 7) ^ ((vr0 >> 1) & 7);
    const int vsw = (r >> 1) & 7, ksw = pr & 15;
    float* xch = (float*)(lds + 2 * AT_STAGE);
    constexpr int NT = TPB / 64;
    bf16x8 Qf[4];
#define ATT_COORDS(QQ, BL, HD, L0, GK, GV) const int pair_##BL = xcd * 8 + ((QQ) >> 5), BL = pair_##BL >> 4, HD = pair_##BL & 15, L0 = ((QQ) & 31) * 128 + qg * 32;          \
        const bf16_t* GK = Kb + ((size_t)BL * TPB + kr0) * DI_ + HD * 128 + kchunk * 8; const bf16_t* GV = Vt + ((size_t)(BL * NH + HD) * 128 + vr0) * TPB + vchunk * 8
#define ATT_LOADQ(BL, HD, L0) do { const bf16_t* qp_ = Qb + ((size_t)BL * SEQ + L0 + r) * DI_ + HD * 128 + 64 * ph + 8 * h;                                               \
        _Pragma("unroll") for (int ks = 0; ks < 4; ++ks) Qf[ks] = *(const bf16x8*)(qp_ + 16 * ks); } while (0)
    WAIT_VM0();
    if (lb < 256) { ATT_COORDS(lb, bl0, hd0, l00, gk0, gv0); attn_issue(gk0, gv0, lds, wave); attn_issue(gk0 + (size_t)64 * DI_, gv0 + 64, lds + AT_STAGE, wave); ATT_LOADQ(bl0, hd0, l00); }
    WAIT_VM0();
    __syncthreads();
    for (int q = lb; q < 256; q += nl) {
        ATT_COORDS(q, bl, hd, l0, gk, gv);
        f32x16 O[4];
#pragma unroll
        for (int i = 0; i < 4; ++i)
#pragma unroll
            for (int j = 0; j < 16; ++j) O[i][j] = 0.f;
        float mm = 0.f, ls = 0.f;
        attn_issue(gk + (size_t)128 * DI_, gv + 128, lds + 2 * AT_STAGE, wave);
        bf16x8 kf0[4];
        attn_read_k(lds + pr * 256, ph, h, ksw, kf0);
        f32x16 NM;
#pragma unroll
        for (int j = 0; j < 16; ++j) NM[j] = 0.f;
        f32x16 Snext = attn_qk(kf0, Qf, NM);
        float mm_n = mm;
        for (int kt = 0; kt < NT; ++kt) {
            const int sc = kt & 3, sn = (kt + 1) & 3, si = (kt + 3) & 3;
            attn_tile(lds + sc * AT_STAGE, lds + sn * AT_STAGE, lds + si * AT_STAGE, kt + 1 < NT, kt + 2 >= NT, kt + 3 < NT,
                      gk + (size_t)(kt + 3) * 64 * DI_, gv + (kt + 3) * 64, wave, kt == 0, pr, ph, h, r, ksw, vsw, Qf, O, Snext, NM, mm_n, mm, ls);
        }
        __syncthreads();
        if (q + nl < 256) { ATT_COORDS(q + nl, bln, hdn, l0n, gkn, gvn); (void)l0n; attn_issue(gkn, gvn, lds, wave); attn_issue(gkn + (size_t)64 * DI_, gvn + 64, lds + AT_STAGE, wave); }
        ls += __shfl_xor(ls, 32);
        const float inv = (ph ? lam : 1.0f) * __builtin_amdgcn_rcpf(ls);
        if (ph) {
#pragma unroll
            for (int vb = 0; vb < 4; ++vb)
#pragma unroll
                for (int j = 0; j < 16; ++j) xch[(qg * 64 + vb * 16 + j) * 64 + lane] = O[vb][j] * inv;
        }
        __syncthreads();
        if (!ph) {
            float ss = 0.f;
#pragma unroll
            for (int vb = 0; vb < 4; ++vb)
#pragma unroll
                for (int j = 0; j < 16; ++j) { const float o = O[vb][j] * inv - xch[(qg * 64 + vb * 16 + j) * 64 + lane]; O[vb][j] = o; ss += o * o; }
            ss += __shfl_xor(ss, 32);
            const float rstd = rsqrtf(ss * (1.0f / 128.f) + EPS) * (1.0f - LAMBDA_INIT);
            const size_t rowoff = ((size_t)bl * SEQ + l0 + r) * DI_ + hd * 128;
#pragma unroll
            for (int vb = 0; vb < 4; ++vb)
#pragma unroll
                for (int g4 = 0; g4 < 4; ++g4) {
                    const int v = vb * 32 + 8 * g4 + 4 * h;
                    const uint2 gt = *(const uint2*)(Gb + rowoff + v);
                    const f32x4 sg = *(const f32x4*)(p.subln_g + v);
                    const float y0 = O[vb][4 * g4] * rstd * sg[0] * siluf_(bf_lo(gt.x)), y1 = O[vb][4 * g4 + 1] * rstd * sg[1] * siluf_(bf_hi(gt.x));
                    const float y2 = O[vb][4 * g4 + 2] * rstd * sg[2] * siluf_(bf_lo(gt.y)), y3 = O[vb][4 * g4 + 3] * rstd * sg[3] * siluf_(bf_hi(gt.y));
                    uint2 o; o.x = pk2(y0, y1); o.y = pk2(y2, y3);
                    *(uint2*)(Y + rowoff + v) = o;
                }
        }
        __builtin_amdgcn_sched_barrier(0);
        if (q + nl < 256) { ATT_COORDS(q + nl, blq, hdq, l0q, gkq, gvq); (void)gkq; (void)gvq; ATT_LOADQ(blq, hdq, l0q); }
        WAIT_VM0();
        __syncthreads();
    }
    __builtin_amdgcn_s_setprio(0);
}

__device__ void phase_final(const Params& p) {
    const int tid_ = opaque_tid(), lane = tid_ & 63, wave = tid_ >> 6;
    for (int R = blockIdx.x * NWV + wave; R < NB * SEQ; R += gridDim.x * NWV) {
        float* row = p.out + (size_t)R * D;
        float4 v[4];
        float ss = 0.f;
#pragma unroll
        for (int i = 0; i < 4; ++i) { v[i] = *(const float4*)(row + (i * 64 + lane) * 4); ss += v[i].x * v[i].x + v[i].y * v[i].y + v[i].z * v[i].z + v[i].w * v[i].w; }
        ss = wave_sum(ss);
        const float rstd = rsqrtf(ss * (1.0f / D) + EPS);
#pragma unroll
        for (int i = 0; i < 4; ++i) {
            const int e = (i * 64 + lane) * 4;
            const float4 gg = *(const float4*)(p.final_g + e);
            float4 o; o.x = v[i].x * rstd * gg.x; o.y = v[i].y * rstd * gg.y; o.z = v[i].z * rstd * gg.z; o.w = v[i].w * rstd * gg.w;
            *(float4*)(row + e) = o;
        }
    }
}


#define XB_TMO      128
#define XB_XCNT(j)  (256  + 64 * (j))
#define XB_XSUB(j)  (1280 + 64 * (j))
#define XB_XGEN(j)  (2304 + 64 * (j))
#define XB_TOP      3328
#define XB_TOPGEN   3392
#define XCD_BAR_WORDS 3456
#define XB_SPIN_CAP (1u << 22)
#define LAS __attribute__((address_space(3)))
DI unsigned xb_ld(unsigned* p)              { return __hip_atomic_load(p, __ATOMIC_RELAXED, __HIP_MEMORY_SCOPE_AGENT); }
DI unsigned xb_add(unsigned* p, unsigned v) { return __hip_atomic_fetch_add(p, v, __ATOMIC_RELAXED, __HIP_MEMORY_SCOPE_AGENT); }
DI unsigned xb_xcc_id() { return (unsigned)__builtin_amdgcn_s_getreg((3 << 11) | 20) & 0xFu; }
#define XB_SPIN(cond, bar) do { unsigned _sp = 0; while (cond) { __builtin_amdgcn_s_sleep(1); \
    if ((++_sp & 255u) == 0u) { if (xb_ld(&(bar)[XB_TMO])) break; if (_sp > XB_SPIN_CAP) { atomicAdd(&(bar)[XB_TMO], 1u); break; } } } } while (0)
struct XcdBarrier { unsigned* bar; unsigned x; volatile LAS unsigned* st; };
DI XcdBarrier xcd_barrier_post(unsigned* bar, volatile LAS unsigned* st) {
    XcdBarrier b; b.bar = bar; b.x = xb_xcc_id(); b.st = st;
    if (threadIdx.x == 0) (void)xb_add(&bar[XB_XCNT(b.x)], 1u);
    return b;
}
DI void xcd_barrier_complete(unsigned* bar, unsigned x, unsigned& nloc, unsigned& nx) {
    const unsigned G = gridDim.x * gridDim.y * gridDim.z;
    unsigned sum, cnt, mine, sp = 0u;
    for (;;) {
        sum = 0u; cnt = 0u; mine = 0u;
#pragma unroll
        for (unsigned j = 0; j < 16; ++j) { const unsigned c = xb_ld(&bar[XB_XCNT(j)]); sum += c; cnt += (c > 0u) ? 1u : 0u; mine = (j == x) ? c : mine; }
        if (sum == G) break;
        __builtin_amdgcn_s_sleep(1);
        if ((++sp & 255u) == 0u) { if (xb_ld(&bar[XB_TMO])) break; if (sp > XB_SPIN_CAP) { atomicAdd(&bar[XB_TMO], 1u); break; } }
    }
    nloc = mine > 0u ? mine : 1u; nx = cnt > 0u ? cnt : 1u;
}
DI void xcd_barrier(const XcdBarrier& b) {
    asm volatile("s_waitcnt vmcnt(0)" ::: "memory");
    __syncthreads();
    if (threadIdx.x == 0) {
        unsigned* bar = b.bar;
        __builtin_amdgcn_s_waitcnt(0);
        unsigned nloc = b.st[0], nx = b.st[1];
        if (nloc == 0u) { xcd_barrier_complete(bar, b.x, nloc, nx); b.st[0] = nloc; b.st[1] = nx; }
        const unsigned old = xb_add(&bar[XB_XSUB(b.x)], 1u);
        const unsigned gen = old / nloc;
        if (old + 1u == (gen + 1u) * nloc) {
            __builtin_amdgcn_fence(__ATOMIC_RELEASE, "agent");
            asm volatile("s_waitcnt vmcnt(0)" ::: "memory");
            const unsigned og = xb_add(&bar[XB_TOP], 1u);
            const unsigned tg = og / nx;
            if (og + 1u == (tg + 1u) * nx) xb_add(&bar[XB_TOPGEN], 1u);
            else XB_SPIN(xb_ld(&bar[XB_TOPGEN]) == tg, bar);
            __builtin_amdgcn_fence(__ATOMIC_ACQUIRE, "agent");
            xb_add(&bar[XB_XGEN(b.x)], 1u);
            asm volatile("s_waitcnt vmcnt(0)" ::: "memory");
        } else {
            XB_SPIN(xb_ld(&bar[XB_XGEN(b.x)]) == gen, bar);
            __builtin_amdgcn_fence(__ATOMIC_ACQUIRE, "agent");
            asm volatile("s_waitcnt vmcnt(0)" ::: "memory");
        }
    }
    __syncthreads();
}
constexpr size_t OFF_BAR = 524288;

constexpr int N_PHASES = 18;
constexpr int LDS_BYTES = 3 * G_STAGEB;
#ifndef PH_MASK
#define PH_MASK 0xffffffffu
#endif
#define EN(k) ((PH_MASK >> (k)) & 1u)
#ifndef REP_MASK
#define REP_MASK 0u
#endif
#define REP(k) ((REP_MASK >> (k)) & 1u)
#define PHASE(k, bit, ...) if (p.ph_begin <= (k) && (k) < p.ph_end) { if (EN(bit)) { __VA_ARGS__; } if (REP(bit)) { __VA_ARGS__; } if ((k) + 1 < p.ph_end && (k) != 5 && (k) != 13) { if ((k) == 0) cg::this_grid().sync(); else xcd_barrier(xb); } }
__global__ void __launch_bounds__(512, 2) fwd_megakernel(Params p) {
    __shared__ __attribute__((aligned(1024))) unsigned char lds[LDS_BYTES + 16];
    unsigned char* ws = p.ws;
    volatile LAS unsigned* xst = (volatile LAS unsigned*)(lds + LDS_BYTES);
    if (threadIdx.x == 0) { xst[0] = 0u; xst[1] = 0u; xst[2] = 0u; xst[3] = 0u; }
    __syncthreads();
    XcdBarrier xb = xcd_barrier_post((unsigned*)(ws + OFF_BAR), xst);
    PHASE(0, 0, phase_prologue(p, (float*)lds))
    PHASE(1, 1, phase_modulate(p, 0, p.x, p.ctx, (unsigned char*)p.out, HG_STRIDE))
#pragma unroll 1
    for (int g = 0; g < 2; ++g) {
        PHASE(2 + 4 * g, 2, EpiPlanes e{(bf16_t*)(ws + OFF_P1), (const float*)(ws + OFF_LB)}; gemmh_phase((const bf16_t*)((unsigned char*)p.out + (size_t)g * HG_STRIDE), (const bf16_t*)(ws + OFF_WT_A), GROWS, 10240, 1024, e, lds))
        PHASE(3 + 4 * g, 3, phase_scan(p, lds))
        PHASE(4 + 4 * g, 4, phase_combine(p))
        PHASE(5 + 4 * g, 5, EpiOut0 e{p.x, p.ctx, (const float*)(ws + OFF_MOD), p.out, (float*)(ws + OFF_X1CTX), g}; gemm_phase((const bf16_t*)(ws + OFF_OF), (const bf16_t*)(ws + OFF_WT_B), GROWS, 1024, 2048, e, lds))
    }
    PHASE(10, 6, phase_convert_da(p, (float*)lds); phase_modulate(p, 1, p.out, (const float*)(ws + OFF_X1CTX), ws + OFF_H1, (size_t)GROWS * D * 2))
#pragma unroll 1
    for (int g = 0; g < 2; ++g) {
        PHASE(11 + 3 * g, 7, EpiDA e{(bf16_t*)(ws + OFF_QB), (bf16_t*)(ws + OFF_KB), (bf16_t*)(ws + OFF_VT), (bf16_t*)(ws + OFF_GB)}; gemmh_phase((const bf16_t*)(ws + OFF_H1 + (size_t)g * GROWS * D * 2), (const bf16_t*)(ws + OFF_WT_A), GROWS, 8192, 1024, e, lds))
        PHASE(12 + 3 * g, 8, phase_attn(p, lds))
        PHASE(13 + 3 * g, 9, EpiOut1 e{(const float*)(ws + OFF_MOD) + 9 * 3072, p.out, g}; gemm_phase((const bf16_t*)(ws + OFF_Y2), (const bf16_t*)(ws + OFF_WT_B), GLAT, 1024, 2048, e, lds))
    }
    PHASE(17, 10, phase_final(p))
}

extern "C" void kernel_launch(void* const* d_in, const int* in_sizes, int n_in, void* d_out, int out_size, void* d_ws, size_t ws_size, hipStream_t stream) {
    if (ws_size < WS_NEED) { fprintf(stderr, "workspace too small: %zu < %zu\n", ws_size, (size_t)WS_NEED); return; }
    static int grid_blocks = 0;
    if (!grid_blocks) {
        int dev = 0, cus = 0, per_cu = 0;
        hipGetDevice(&dev);
        hipDeviceGetAttribute(&cus, hipDeviceAttributeMultiprocessorCount, dev);
        hipOccupancyMaxActiveBlocksPerMultiprocessor(&per_cu, fwd_megakernel, NTH, 0);
        if (per_cu > 1) per_cu = 1;
        grid_blocks = cus * per_cu;
        if (grid_blocks < 8) grid_blocks = 8;
        grid_blocks &= ~7;
    }
    hipMemsetAsync((unsigned char*)d_ws + OFF_BAR, 0, XCD_BAR_WORDS * sizeof(unsigned), stream);
    Params p{};
    const float** f = (const float**)&p;
    for (int i = 0; i < 19; ++i) f[i] = (const float*)d_in[i];
    p.out = (float*)d_out; p.ws = (unsigned char*)d_ws;
#if MULTI_LAUNCH
    for (int ph = 0; ph < N_PHASES; ++ph) { p.ph_begin = ph; p.ph_end = ph + 1; hipLaunchKernelGGL(fwd_megakernel, dim3(grid_blocks), dim3(NTH), 0, stream, p); }
#else
    p.ph_begin = 0; p.ph_end = N_PHASES;
    void* args[] = {&p};
    hipError_t e = hipLaunchCooperativeKernel((void*)fwd_megakernel, dim3(grid_blocks), dim3(NTH), args, 0, stream);
    if (e != hipSuccess) fprintf(stderr, "cooperative launch failed: %s (grid %d)\n", hipGetErrorString(e), grid_blocks);
#endif
}
```
